# Optimizing an MI355X kernel written in HIP

```python
import math
import jax, jax.numpy as jnp
from jax import lax
import numpy as np

D_MODEL = 1024
BATCH = 4
SEQ = 4096
DEPTH = 1

MIX_WIDTH = D_MODEL
DIFF_WIDTH = MIX_WIDTH // 2
GLA_WIDTH = MIX_WIDTH - DIFF_WIDTH
DIFF_DH = 64
DIFF_HEADS = DIFF_WIDTH // (2 * DIFF_DH)
Q_BLOCK = 128
GLA_HEADS = 4
GLA_DV = GLA_WIDTH // GLA_HEADS
GLA_DK = GLA_DV // 2
GLA_RANK = 16
GLA_TAU = 16.0
GLA_CHUNK = 64
D_FF = 2816
CONV_W = 3
ROPE_THETA = 10000.0
LN_EPS = 1e-5
DN_ALPHA = (2.0 * DEPTH) ** 0.25
DN_BETA = (8.0 * DEPTH) ** -0.25

N_DQ = DIFF_HEADS * 2 * DIFF_DH
N_DK = DIFF_HEADS * 2 * DIFF_DH
N_DV = DIFF_WIDTH
N_GQ = GLA_HEADS * GLA_DK
N_GK = GLA_HEADS * GLA_DK
N_GV = GLA_WIDTH
N_GR = GLA_WIDTH
N_GG = GLA_RANK
IN_SPLITS = tuple(np.cumsum([N_DQ, N_DK, N_DV, N_GQ, N_GK, N_GV, N_GR])[:].tolist())
N_IN = N_DQ + N_DK + N_DV + N_GQ + N_GK + N_GV + N_GR + N_GG

kernel_name = "hymba_diffattn_gla_convffn_deepnorm_adaln"


def layer_norm(x, g, b):
    xf = x.astype(jnp.float32)
    mu = jnp.mean(xf, axis=-1, keepdims=True)
    var = jnp.mean(jnp.square(xf - mu), axis=-1, keepdims=True)
    return ((xf - mu) * lax.rsqrt(var + LN_EPS) * g + b).astype(x.dtype)


def rms_norm(x, w):
    xf = x.astype(jnp.float32)
    return (xf * lax.rsqrt(jnp.mean(jnp.square(xf), axis=-1, keepdims=True) + LN_EPS) * w).astype(x.dtype)


def rope_tables(positions, dim):
    inv = ROPE_THETA ** (-jnp.arange(0, dim, 2, dtype=jnp.float32) / dim)
    ang = positions.astype(jnp.float32)[..., None] * inv
    return jnp.cos(ang), jnp.sin(ang)


def apply_rope(x, cos, sin):
    half = x.shape[-1] // 2
    x1, x2 = x[..., :half].astype(jnp.float32), x[..., half:].astype(jnp.float32)
    return jnp.concatenate([x1 * cos - x2 * sin, x2 * cos + x1 * sin], axis=-1).astype(x.dtype)


def diff_attention(q, k, v, lam):
    B, S, H, _, dh = q.shape
    nb = S // Q_BLOCK
    qb = q.reshape(B, nb, Q_BLOCK, H, 2, dh).transpose(1, 0, 3, 4, 2, 5)
    kt = k.transpose(0, 2, 3, 1, 4)
    vt = v.transpose(0, 2, 1, 3)
    key_idx = jnp.arange(S)
    scale = 1.0 / math.sqrt(dh)

    def block(args):
        qi, i = args
        s = jnp.einsum('bhmqd,bhmkd->bhmqk', qi, kt).astype(jnp.float32) * scale
        q_idx = i * Q_BLOCK + jnp.arange(Q_BLOCK)
        mask = key_idx[None, :] <= q_idx[:, None]
        p = jax.nn.softmax(jnp.where(mask, s, -jnp.inf), axis=-1)
        a = p[:, :, 0] - lam * p[:, :, 1]
        return jnp.einsum('bhqk,bhkv->bhqv', a.astype(vt.dtype), vt)

    o = lax.map(block, (qb, jnp.arange(nb)))
    return o.transpose(1, 0, 3, 2, 4).reshape(B, S, H, 2 * dh)


def gla_chunked(q, k, v, g):
    B, S, H, dk = q.shape
    dv = v.shape[-1]
    n = S // GLA_CHUNK

    def chunks(t):
        return t.astype(jnp.float32).reshape(B, n, GLA_CHUNK, H, t.shape[-1]).transpose(1, 0, 3, 2, 4)

    qc, kc, vc, gc = chunks(q), chunks(k), chunks(v), chunks(g)
    bc = jnp.cumsum(gc, axis=-2)
    causal = jnp.tril(jnp.ones((GLA_CHUNK, GLA_CHUNK), dtype=bool))[:, :, None]

    def step(state, inp):
        qi, ki, vi, bi = inp
        diff = bi[:, :, :, None, :] - bi[:, :, None, :, :]
        decay = jnp.exp(jnp.where(causal, diff, -jnp.inf))
        attn = jnp.einsum('bhid,bhjd,bhijd->bhij', qi, ki, decay)
        o = attn @ vi + jnp.einsum('bhid,bhdv->bhiv', qi * jnp.exp(bi), state)
        b_last = bi[:, :, -1:, :]
        state = jnp.exp(b_last[:, :, 0, :])[..., None] * state + \
            jnp.einsum('bhjd,bhjv->bhdv', ki * jnp.exp(b_last - bi), vi)
        return state, o

    s0 = jnp.zeros((B, H, dk, dv), jnp.float32)
    _, o = lax.scan(step, s0, (qc, kc, vc, bc))
    return o.transpose(1, 0, 3, 2, 4).reshape(B, S, H, dv).astype(v.dtype)


def causal_depthwise_conv(h, w, b):
    S = h.shape[1]
    hp = jnp.pad(h, ((0, 0), (CONV_W - 1, 0), (0, 0)))
    out = b
    for j in range(CONV_W):
        out = out + w[j] * hp[:, j:j + S]
    return out


def setup_inputs(seed: int = 0) -> dict:
    key = jax.random.key(seed)
    ks = jax.random.split(key, 28)
    L, D, F = DEPTH, D_MODEL, D_FF

    def nrm(k, shape, scale):
        return jax.random.normal(k, shape, jnp.float32) * scale

    col_scale = jnp.concatenate([
        jnp.full((N_DQ + N_DK,), 1.0), jnp.full((N_DV,), DN_BETA),
        jnp.full((N_GQ + N_GK,), 1.0), jnp.full((N_GV,), DN_BETA),
        jnp.full((N_GR + N_GG,), 1.0)]).astype(jnp.float32) * D ** -0.5
    offsets = jax.random.randint(ks[2], (BATCH, 1), 0, 1024)
    positions = (offsets + jnp.arange(SEQ, dtype=jnp.int32)[None, :]).astype(jnp.int32)
    return {
        'x': nrm(ks[0], (BATCH, SEQ, D), 1.0),
        'c': nrm(ks[1], (BATCH, D), 1.0),
        'positions': positions,
        'ln_in_g': 1.0 + nrm(ks[3], (D,), 0.02),
        'ln_in_b': nrm(ks[4], (D,), 0.02),
        'w_ada': nrm(ks[5], (L, D, 6 * D), 0.2 * D ** -0.5),
        'b_ada': nrm(ks[6], (L, 6 * D), 0.02),
        'w_in': nrm(ks[7], (L, D, N_IN), 1.0) * col_scale,
        'lambda_q1': nrm(ks[8], (L, DIFF_DH), 0.1),
        'lambda_k1': nrm(ks[9], (L, DIFF_DH), 0.1),
        'lambda_q2': nrm(ks[10], (L, DIFF_DH), 0.1),
        'lambda_k2': nrm(ks[11], (L, DIFF_DH), 0.1),
        'diff_norm_w': 1.0 + nrm(ks[12], (L, 2 * DIFF_DH), 0.02),
        'gla_w_gate_up': nrm(ks[13], (L, GLA_RANK, GLA_HEADS * GLA_DK), GLA_RANK ** -0.5),
        'gla_b_gate': nrm(ks[14], (L, GLA_HEADS * GLA_DK), 0.1),
        'gla_norm_w': 1.0 + nrm(ks[15], (L, GLA_DV), 0.02),
        'w_out': nrm(ks[16], (L, MIX_WIDTH, D), DN_BETA * MIX_WIDTH ** -0.5),
        'ln_attn_g': 1.0 + nrm(ks[17], (L, D), 0.02),
        'ln_attn_b': nrm(ks[18], (L, D), 0.02),
        'w_up': nrm(ks[19], (L, D, 2 * F), D ** -0.5),
        'conv_w': nrm(ks[20], (L, CONV_W, 2 * F), CONV_W ** -0.5),
        'conv_b': nrm(ks[21], (L, 2 * F), 0.02),
        'w_down': nrm(ks[22], (L, F, D), DN_BETA * F ** -0.5),
        'ln_ffn_g': 1.0 + nrm(ks[23], (L, D), 0.02),
        'ln_ffn_b': nrm(ks[24], (L, D), 0.02),
    }


def reference(x, c, positions, ln_in_g, ln_in_b, w_ada, b_ada, w_in, lambda_q1, lambda_k1,
              lambda_q2, lambda_k2, diff_norm_w, gla_w_gate_up, gla_b_gate, gla_norm_w, w_out,
              ln_attn_g, ln_attn_b, w_up, conv_w, conv_b, w_down, ln_ffn_g, ln_ffn_b):
    B, S, D = x.shape
    cos, sin = rope_tables(positions, DIFF_DH)
    cos_d, sin_d = cos[:, :, None, None, :], sin[:, :, None, None, :]
    c_act = jax.nn.silu(c)
    h = layer_norm(x, ln_in_g, ln_in_b)

    for l in range(DEPTH):
        lambda_init = 0.8 - 0.6 * math.exp(-0.3 * l)
        ada = c_act @ w_ada[l] + b_ada[l]
        sh_a, sc_a, gt_a, sh_f, sc_f, gt_f = [t[:, None, :] for t in jnp.split(ada, 6, axis=-1)]

        u = h * (1.0 + sc_a) + sh_a
        proj = u @ w_in[l]
        dq, dk_, dv, gq, gk, gv, gr, gg = jnp.split(proj, IN_SPLITS, axis=-1)

        dq = apply_rope(dq.reshape(B, S, DIFF_HEADS, 2, DIFF_DH), cos_d, sin_d)
        dk_ = apply_rope(dk_.reshape(B, S, DIFF_HEADS, 2, DIFF_DH), cos_d, sin_d)
        dv = dv.reshape(B, S, DIFF_HEADS, 2 * DIFF_DH)
        lam = (jnp.exp(jnp.sum(lambda_q1[l].astype(jnp.float32) * lambda_k1[l]))
               - jnp.exp(jnp.sum(lambda_q2[l].astype(jnp.float32) * lambda_k2[l])) + lambda_init)
        d_out = diff_attention(dq, dk_, dv, lam)
        d_out = (rms_norm(d_out, diff_norm_w[l]) * (1.0 - lambda_init)).reshape(B, S, DIFF_WIDTH)

        gq = gq.reshape(B, S, GLA_HEADS, GLA_DK) * (GLA_DK ** -0.5)
        gk = gk.reshape(B, S, GLA_HEADS, GLA_DK)
        gv = gv.reshape(B, S, GLA_HEADS, GLA_DV)
        glog = jax.nn.log_sigmoid((gg @ gla_w_gate_up[l] + gla_b_gate[l]).astype(jnp.float32)) / GLA_TAU
        g_out = gla_chunked(gq, gk, gv, glog.reshape(B, S, GLA_HEADS, GLA_DK))
        g_out = rms_norm(g_out, gla_norm_w[l]).reshape(B, S, GLA_WIDTH) * jax.nn.silu(gr)

        mix = jnp.concatenate([d_out, g_out], axis=-1) @ w_out[l]
        h = layer_norm(DN_ALPHA * h + (1.0 + gt_a) * mix, ln_attn_g[l], ln_attn_b[l])

        u = h * (1.0 + sc_f) + sh_f
        up = causal_depthwise_conv(u @ w_up[l], conv_w[l], conv_b[l])
        a, bgate = jnp.split(up, 2, axis=-1)
        ff = (jax.nn.silu(a) * bgate) @ w_down[l]
        h = layer_norm(DN_ALPHA * h + (1.0 + gt_f) * ff, ln_ffn_g[l], ln_ffn_b[l])

    return h
```

```cpp
#include <hip/hip_runtime.h>
#include <hip/hip_cooperative_groups.h>
#include <stdint.h>
#include <stdio.h>
namespace cg = cooperative_groups;

#ifndef ONE_LAUNCH
#define ONE_LAUNCH 0
#endif

typedef unsigned short bf16_t;
typedef short bf16x8 __attribute__((ext_vector_type(8)));
typedef float f32x4 __attribute__((ext_vector_type(4)));
typedef unsigned u32x4 __attribute__((ext_vector_type(4)));
typedef unsigned u32x2 __attribute__((ext_vector_type(2)));

constexpr int D = 1024, BATCH = 4, SEQ = 4096, M = BATCH * SEQ;
constexpr int NH = 4;
constexpr int N_INX = 3328;
constexpr int F = 2816, F2 = 5632;
constexpr float LN_EPS = 1e-5f;
constexpr float DN_ALPHA = 1.189207115002721f;
constexpr float LAMBDA_INIT = 0.2f;
constexpr float QSCALE = 0.125f * 1.4426950408889634f;

constexpr size_t MiB = 1u << 20;
constexpr size_t WS_CTL = 0;
constexpr size_t WS_ADA = 1 * MiB;
constexpr size_t WS_STATS = 1 * MiB + 256 * 1024;
constexpr size_t WS_COS = 2 * MiB, WS_SIN = 4 * MiB;
constexpr size_t WS_WIN = 6 * MiB;
constexpr size_t WS_WOUT = 13 * MiB;
constexpr size_t WS_WUP = 15 * MiB;
constexpr size_t WS_WDOWN = 26 * MiB;
constexpr size_t WS_XN = 32 * MiB + 4096;
constexpr size_t WS_BIG = 65 * MiB;
constexpr size_t WS_DQ = WS_BIG, WS_DK = WS_BIG + 16 * MiB, WS_DV = WS_BIG + 32 * MiB;
constexpr size_t WS_GQ = WS_BIG + 48 * MiB, WS_GK = WS_BIG + 56 * MiB;
constexpr size_t WS_GV = WS_BIG + 64 * MiB, WS_GR = WS_BIG + 80 * MiB;
constexpr size_t WS_GLOG = WS_BIG + 96 * MiB;
constexpr size_t WS_MIX = WS_BIG + 112 * MiB;
constexpr size_t WS_GLU = WS_BIG + 144 * MiB;
constexpr size_t WS_UPH = WS_BIG;
constexpr size_t WS_ACTH = WS_BIG + 88 * MiB;
constexpr size_t WS_END = 256 * MiB;

struct Params {
    const float* x; const float* c; const int* pos; const float* ln_in_g; const float* ln_in_b;
    const float* w_ada; const float* b_ada; const float* w_in;
    const float* lq1; const float* lk1; const float* lq2; const float* lk2;
    const float* diff_norm_w; const float* w_gate_up; const float* b_gate; const float* gla_norm_w;
    const float* w_out; const float* ln_attn_g; const float* ln_attn_b;
    const float* w_up; const float* conv_w; const float* conv_b; const float* w_down;
    const float* ln_ffn_g; const float* ln_ffn_b;
    float* out; unsigned char* ws;
};

__device__ __forceinline__ unsigned f2bf(float f) { unsigned u = __builtin_bit_cast(unsigned, f); return (u + 0x7fffu + ((u >> 16) & 1u)) >> 16; }
__device__ __forceinline__ unsigned pk2(float lo, float hi) { return f2bf(lo) | (f2bf(hi) << 16); }
__device__ __forceinline__ float bf2f(unsigned short b) { return __builtin_bit_cast(float, (unsigned)b << 16); }
__device__ __forceinline__ float bflo(unsigned w) { return __builtin_bit_cast(float, w << 16); }
__device__ __forceinline__ float bfhi(unsigned w) { return __builtin_bit_cast(float, w & 0xffff0000u); }
__device__ __forceinline__ float wave_sum(float v) {
#pragma unroll
    for (int o = 1; o < 64; o <<= 1) v += __shfl_xor(v, o);
    return v;
}
__device__ __forceinline__ float silu_f(float v) { return v / (1.0f + __expf(-v)); }
__device__ __forceinline__ float lambda_full(const Params& p) {
    float s1 = 0.f, s2 = 0.f;
    for (int i = 0; i < 64; ++i) { s1 += p.lq1[i] * p.lk1[i]; s2 += p.lq2[i] * p.lk2[i]; }
    return expf(s1) - expf(s2) + LAMBDA_INIT;
}

__device__ void phase_ada(const Params& p, float* smem, int bid, int nb) {
    float* ada = (float*)(p.ws + WS_ADA);
    const int t = threadIdx.x, nt = blockDim.x, cgp = t & 7, kl = t >> 3, nkl = nt >> 3;
    for (int item = bid; item < 6144 / 32; item += nb) {
        const int n0 = item * 32;
        float acc[4][4];
#pragma unroll
        for (int b = 0; b < 4; ++b)
#pragma unroll
            for (int j = 0; j < 4; ++j) acc[b][j] = 0.f;
        for (int k = kl; k < D; k += nkl) {
            const f32x4 w = *(const f32x4*)(p.w_ada + (size_t)k * 6144 + n0 + 4 * cgp);
#pragma unroll
            for (int b = 0; b < 4; ++b) { const float ca = silu_f(p.c[b * D + k]);
#pragma unroll
                for (int j = 0; j < 4; ++j) acc[b][j] += ca * w[j]; }
        }
        __syncthreads();
#pragma unroll
        for (int b = 0; b < 4; ++b)
#pragma unroll
            for (int j = 0; j < 4; ++j) smem[(kl * 32 + 4 * cgp + j) * 4 + b] = acc[b][j];
        __syncthreads();
        if (t < 128) { const int col = t & 31, b = t >> 5; float s = 0.f;
            for (int q = 0; q < nkl; ++q) s += smem[(q * 32 + col) * 4 + b];
            ada[b * 6144 + n0 + col] = s + p.b_ada[n0 + col]; }
    }
}

__device__ __forceinline__ void wprep_tile(const Params& p, float* tile  , int kind, int tn, int tk) {
    const int t = threadIdx.x, nt = blockDim.x, tx = t & 63, ty = t >> 6, nty = nt >> 6;
    const float* W; int N, K; bf16_t* WT;
    if (kind == 0) { W = p.w_in; N = 3088; K = D; WT = (bf16_t*)(p.ws + WS_WIN); }
    else if (kind == 1) { W = p.w_out; N = D; K = D; WT = (bf16_t*)(p.ws + WS_WOUT); }
    else if (kind == 2) { W = p.w_up; N = F2; K = D; WT = (bf16_t*)(p.ws + WS_WUP); }
    else { W = p.w_down; N = D; K = F; WT = (bf16_t*)(p.ws + WS_WDOWN); }
    const int n0 = tn * 64, k0 = tk * 64, np = n0 + tx;
    __syncthreads();
    if (kind == 0 && n0 >= 3072) {
        const int j = np - 3072;
        float g[16];
#pragma unroll
        for (int r = 0; r < 16; ++r) g[r] = p.w_gate_up[r * 256 + j];
        for (int kk = ty; kk < 64; kk += nty) { const float* wr = W + (size_t)(k0 + kk) * N + 3072; float s = 0.f;
#pragma unroll
            for (int r = 0; r < 16; ++r) s += wr[r] * g[r];
            tile[kk * 65 + tx] = s; }
    } else {
        int src;
        if (kind == 0) { if (np < 1024) { const int pp = np & 63; src = (np & ~63) + (pp >> 1) + 32 * (pp & 1); } else src = np; }
        else if (kind == 2) { const int pn = np >> 8, w = np & 255; src = (w < 128) ? (128 * pn + w) : (F + 128 * pn + (w - 128)); }
        else src = np;
        for (int kk = ty; kk < 64; kk += nty) tile[kk * 65 + tx] = W[(size_t)(k0 + kk) * N + src];
    }
    __syncthreads();
    for (int nn = ty; nn < 64; nn += nty) WT[(size_t)(n0 + nn) * K + k0 + tx] = (bf16_t)f2bf(tile[tx * 65 + nn]);
}
__device__ void phase_wprep(const Params& p, float* smem, int bid, int nb) {
    constexpr int T0 = (N_INX / 64) * (D / 64), T1 = (D / 64) * (D / 64), T2 = (F2 / 64) * (D / 64), T3 = (D / 64) * (F / 64);
    for (int it = bid; it < T0 + T1 + T2 + T3; it += nb) {
        int r = it;
        if (r < T0) { wprep_tile(p, smem, 0, r / (D / 64), r % (D / 64)); continue; } r -= T0;
        if (r < T1) { wprep_tile(p, smem, 1, r / (D / 64), r % (D / 64)); continue; } r -= T1;
        if (r < T2) { wprep_tile(p, smem, 2, r / (D / 64), r % (D / 64)); continue; } r -= T2;
        wprep_tile(p, smem, 3, r / (F / 64), r % (F / 64));
    }
}

__device__ void phase_rope(const Params& p, int bid, int nb) {
    float* COS = (float*)(p.ws + WS_COS); float* SIN = (float*)(p.ws + WS_SIN);
    for (int e = bid * blockDim.x + threadIdx.x; e < M * 32; e += nb * blockDim.x) {
        const int m = e >> 5, i = e & 31;
        double inv = 1.0; const double r = 0.74989420933245582730;
        for (int q = 0; q < i; ++q) inv *= r;
        const float invf = (float)inv;
        const double a = (double)((float)p.pos[m] * invf);
        const double qd = __builtin_rint(a * 0.63661977236758134308);
        const double rr = __builtin_fma(-qd, 1.57079632679489661923, a);
        const float x = (float)rr, x2 = x * x;
        const float s = x * (1.f + x2 * (-1.f / 6.f + x2 * (1.f / 120.f + x2 * (-1.f / 5040.f + x2 * (1.f / 362880.f)))));
        const float cc = 1.f + x2 * (-0.5f + x2 * (1.f / 24.f + x2 * (-1.f / 720.f + x2 * (1.f / 40320.f + x2 * (-1.f / 3628800.f)))));
        const int qi = (int)((long long)qd & 3);
        float co, si;
        if (qi == 0) { co = cc; si = s; } else if (qi == 1) { co = -s; si = cc; } else if (qi == 2) { co = -cc; si = -s; } else { co = s; si = -cc; }
        COS[e] = co; SIN[e] = si;
    }
}

__device__ __forceinline__ void ln_stats(const f32x4 (&v)[4], float& mean, float& rstd) {
    float s = 0.f;
#pragma unroll
    for (int j = 0; j < 4; ++j) s += (v[j].x + v[j].y) + (v[j].z + v[j].w);
    mean = wave_sum(s) * (1.f / D); float s2 = 0.f;
#pragma unroll
    for (int j = 0; j < 4; ++j) { const f32x4 d = v[j] - mean; s2 += (d.x * d.x + d.y * d.y) + (d.z * d.z + d.w * d.w); }
    rstd = 1.0f / sqrtf(wave_sum(s2) * (1.f / D) + LN_EPS);
}
__device__ void phase_ln_in(const Params& p, int bid, int nb) {
    const float* ada = (const float*)(p.ws + WS_ADA); float* stats = (float*)(p.ws + WS_STATS); bf16_t* XN = (bf16_t*)(p.ws + WS_XN);
    const int lane = threadIdx.x & 63, wpb = blockDim.x >> 6, gw = bid * wpb + (threadIdx.x >> 6), ngw = nb * wpb;
    for (int m = gw; m < M; m += ngw) {
        const int b = m / SEQ;
        const f32x4* xr = (const f32x4*)(p.x + (size_t)m * D) + lane;
        f32x4 v[4];
#pragma unroll
        for (int j = 0; j < 4; ++j) v[j] = xr[64 * j];
        float mean, rstd; ln_stats(v, mean, rstd);
        if (lane == 0) { stats[2 * m] = mean; stats[2 * m + 1] = rstd; }
        u32x2* o8 = (u32x2*)(XN + (size_t)m * D) + lane;
#pragma unroll
        for (int j = 0; j < 4; ++j) {
            const int col = 4 * lane + 256 * j;
            const f32x4 g = *(const f32x4*)(p.ln_in_g + col), bb = *(const f32x4*)(p.ln_in_b + col);
            const f32x4 sh = *(const f32x4*)(ada + b * 6144 + col), sc = *(const f32x4*)(ada + b * 6144 + 1024 + col);
            const f32x4 h = (v[j] - mean) * rstd * g + bb;
            const f32x4 u = h * (1.0f + sc) + sh;
            u32x2 w; w.x = pk2(u.x, u.y); w.y = pk2(u.z, u.w); o8[64 * j] = w;
        }
    }
}
__device__ void phase_ln_rows(const Params& p, float* R, const float* g, const float* bb, bf16_t* XN2, int sh_off, int sc_off, int bid, int nb) {
    const float* ada = (const float*)(p.ws + WS_ADA);
    const int lane = threadIdx.x & 63, wpb = blockDim.x >> 6, gw = bid * wpb + (threadIdx.x >> 6), ngw = nb * wpb;
    for (int m = gw; m < M; m += ngw) {
        const int b = m / SEQ;
        f32x4* xr = (f32x4*)(R + (size_t)m * D) + lane;
        f32x4 v[4];
#pragma unroll
        for (int j = 0; j < 4; ++j) v[j] = xr[64 * j];
        float mean, rstd; ln_stats(v, mean, rstd);
#pragma unroll
        for (int j = 0; j < 4; ++j) {
            const int col = 4 * lane + 256 * j;
            const f32x4 gg = *(const f32x4*)(g + col), b4 = *(const f32x4*)(bb + col);
            const f32x4 h = (v[j] - mean) * rstd * gg + b4;
            xr[64 * j] = h;
            if (XN2) {
                const f32x4 sh = *(const f32x4*)(ada + b * 6144 + sh_off + col), sc = *(const f32x4*)(ada + b * 6144 + sc_off + col);
                const f32x4 u = h * (1.0f + sc) + sh;
                u32x2 w; w.x = pk2(u.x, u.y); w.y = pk2(u.z, u.w); ((u32x2*)(XN2 + (size_t)m * D) + lane)[64 * j] = w;
            }
        }
    }
}

template <class Epi>
__device__ void gemm_simple(const bf16_t* A, int lda, const bf16_t* Bt, int ldb, int Mrows, int N, int K, const Epi& epi, int bid, int nb) {
    const int lane = threadIdx.x & 63, fr = lane & 15, fq = lane >> 4, wpb = blockDim.x >> 6, gw = bid * wpb + (threadIdx.x >> 6), ngw = nb * wpb;
    const int ntn = N / 32, ntiles = (Mrows / 32) * ntn;
    for (int tile = gw; tile < ntiles; tile += ngw) {
        const int m0 = (tile / ntn) * 32, n0 = (tile % ntn) * 32;
        f32x4 acc[2][2];
#pragma unroll
        for (int i = 0; i < 2; ++i)
#pragma unroll
            for (int j = 0; j < 2; ++j) acc[i][j] = (f32x4){0.f, 0.f, 0.f, 0.f};
        const bf16_t* ap = A + (size_t)(m0 + fr) * lda + 8 * fq;
        const bf16_t* bp = Bt + (size_t)(n0 + fr) * ldb + 8 * fq;
#pragma unroll 4
        for (int k0 = 0; k0 < K; k0 += 32) {
            bf16x8 a[2], b[2];
            a[0] = *(const bf16x8*)(ap + k0); a[1] = *(const bf16x8*)(ap + (size_t)16 * lda + k0);
            b[0] = *(const bf16x8*)(bp + k0); b[1] = *(const bf16x8*)(bp + (size_t)16 * ldb + k0);
#pragma unroll
            for (int i = 0; i < 2; ++i)
#pragma unroll
                for (int j = 0; j < 2; ++j) acc[i][j] = __builtin_amdgcn_mfma_f32_16x16x32_bf16(b[j], a[i], acc[i][j], 0, 0, 0);
        }
#pragma unroll
        for (int i = 0; i < 2; ++i)
#pragma unroll
            for (int j = 0; j < 2; ++j) epi(m0 + 16 * i + fr, n0 + 16 * j + 4 * fq, acc[i][j]);
    }
}

struct EpiIn {
    unsigned char* ws; const float* b_gate;
    __device__ __forceinline__ void operator()(int row, int col0, f32x4 v) const {
        if (col0 < 1024) {
            const int i0 = (col0 & 63) >> 1;
            const float* COS = (const float*)(ws + WS_COS) + (size_t)row * 32 + i0; const float* SIN = (const float*)(ws + WS_SIN) + (size_t)row * 32 + i0;
            const float c0 = COS[0], c1 = COS[1], s0 = SIN[0], s1 = SIN[1];
            float o0 = v[0] * c0 - v[1] * s0, o1 = v[1] * c0 + v[0] * s0, o2 = v[2] * c1 - v[3] * s1, o3 = v[3] * c1 + v[2] * s1;
            bf16_t* dst;
            if (col0 < 512) { o0 *= QSCALE; o1 *= QSCALE; o2 *= QSCALE; o3 *= QSCALE; dst = (bf16_t*)(ws + WS_DQ) + (size_t)row * 512 + col0; }
            else dst = (bf16_t*)(ws + WS_DK) + (size_t)row * 512 + (col0 - 512);
            u32x2 w; w.x = pk2(o0, o1); w.y = pk2(o2, o3); *(u32x2*)dst = w;
        } else if (col0 < 3072) {
            bf16_t* dst;
            if (col0 < 1536) dst = (bf16_t*)(ws + WS_DV) + (size_t)row * 512 + (col0 - 1024);
            else if (col0 < 1792) { v = v * 0.125f; dst = (bf16_t*)(ws + WS_GQ) + (size_t)row * 256 + (col0 - 1536); }
            else if (col0 < 2048) dst = (bf16_t*)(ws + WS_GK) + (size_t)row * 256 + (col0 - 1792);
            else if (col0 < 2560) dst = (bf16_t*)(ws + WS_GV) + (size_t)row * 512 + (col0 - 2048);
            else { v = (f32x4){silu_f(v[0]), silu_f(v[1]), silu_f(v[2]), silu_f(v[3])}; dst = (bf16_t*)(ws + WS_GR) + (size_t)row * 512 + (col0 - 2560); }
            u32x2 w; w.x = pk2(v[0], v[1]); w.y = pk2(v[2], v[3]); *(u32x2*)dst = w;
        } else {
            const int j = col0 - 3072; f32x4 o;
#pragma unroll
            for (int q = 0; q < 4; ++q) { const float z = v[q] + b_gate[j + q]; o[q] = (fminf(z, 0.f) - __logf(1.0f + __expf(-fabsf(z)))) * (1.0f / 16.0f); }
            *(f32x4*)((float*)(ws + WS_GLOG) + (size_t)row * 256 + j) = o;
        }
    }
};
struct EpiOut {
    const Params* p;
    __device__ __forceinline__ void operator()(int row, int col0, f32x4 v) const {
        const float* ada = (const float*)(p->ws + WS_ADA); const float* stats = (const float*)(p->ws + WS_STATS);
        const int b = row / SEQ; const float mean = stats[2 * row], rstd = stats[2 * row + 1];
        const f32x4 xv = *(const f32x4*)(p->x + (size_t)row * D + col0), g = *(const f32x4*)(p->ln_in_g + col0), bb = *(const f32x4*)(p->ln_in_b + col0);
        const f32x4 gt = *(const f32x4*)(ada + b * 6144 + 2048 + col0);
        const f32x4 h0 = (xv - mean) * rstd * g + bb;
        *(f32x4*)(p->out + (size_t)row * D + col0) = h0 * DN_ALPHA + (1.0f + gt) * v;
    }
};
struct EpiUpRaw {
    bf16_t* UP; int row_off;
    __device__ __forceinline__ void operator()(int row, int col0, f32x4 v) const {
        u32x2 w; w.x = pk2(v[0], v[1]); w.y = pk2(v[2], v[3]); *(u32x2*)(UP + (size_t)row * F2 + col0) = w;
    }
};
struct EpiDown {
    const Params* p; int row_off;
    __device__ __forceinline__ void operator()(int row, int col0, f32x4 v) const {
        const float* ada = (const float*)(p->ws + WS_ADA);
        const int grow = row + row_off, b = grow / SEQ;
        const f32x4 gt = *(const f32x4*)(ada + b * 6144 + 5120 + col0);
        f32x4* o = (f32x4*)(p->out + (size_t)grow * D + col0);
        *o = (*o) * DN_ALPHA + (1.0f + gt) * v;
    }
};

__device__ void phase_attn_naive(const Params& p, float* DIFF, int bid, int nb) {
    const bf16_t* DQ = (const bf16_t*)(p.ws + WS_DQ); const bf16_t* DK = (const bf16_t*)(p.ws + WS_DK); const bf16_t* DV = (const bf16_t*)(p.ws + WS_DV);
    const float lam = lambda_full(p);
    const int total = BATCH * NH * SEQ * 4;
    for (int w = bid * blockDim.x + threadIdx.x; w < total; w += nb * blockDim.x) {
        const int sl = w & 3, bh = (w >> 2) & 15, i = SEQ - 1 - (w >> 6), b = bh >> 2, h = bh & 3;
        const size_t rowq = (size_t)b * SEQ + i;
        float o0[32];
#pragma unroll
        for (int mp = 0; mp < 2; ++mp) {
            float q[64];
            { const u32x4* qp = (const u32x4*)(DQ + rowq * 512 + h * 128 + mp * 64);
#pragma unroll
              for (int c8 = 0; c8 < 8; ++c8) { const u32x4 u = qp[c8];
                  q[8 * c8 + 0] = bflo(u.x); q[8 * c8 + 1] = bfhi(u.x); q[8 * c8 + 2] = bflo(u.y); q[8 * c8 + 3] = bfhi(u.y);
                  q[8 * c8 + 4] = bflo(u.z); q[8 * c8 + 5] = bfhi(u.z); q[8 * c8 + 6] = bflo(u.w); q[8 * c8 + 7] = bfhi(u.w); } }
            float o[32];
#pragma unroll
            for (int e = 0; e < 32; ++e) o[e] = 0.f;
            float mx = -INFINITY, l = 0.f;
            for (int j = 0; j <= i; ++j) {
                const size_t rowk = (size_t)b * SEQ + j;
                const u32x4* kp = (const u32x4*)(DK + rowk * 512 + h * 128 + mp * 64);
                float s0 = 0.f, s1 = 0.f;
#pragma unroll
                for (int c8 = 0; c8 < 8; ++c8) { const u32x4 u = kp[c8];
                    s0 += q[8 * c8 + 0] * bflo(u.x); s1 += q[8 * c8 + 1] * bfhi(u.x); s0 += q[8 * c8 + 2] * bflo(u.y); s1 += q[8 * c8 + 3] * bfhi(u.y);
                    s0 += q[8 * c8 + 4] * bflo(u.z); s1 += q[8 * c8 + 5] * bfhi(u.z); s0 += q[8 * c8 + 6] * bflo(u.w); s1 += q[8 * c8 + 7] * bfhi(u.w); }
                const float s = s0 + s1;
                float pr;
                if (s > mx) { const float f = exp2f(mx - s); l = l * f + 1.f;
#pragma unroll
                    for (int e = 0; e < 32; ++e) o[e] *= f;
                    mx = s; pr = 1.f; }
                else { pr = exp2f(s - mx); l += pr; }
                const u32x4* vp = (const u32x4*)(DV + rowk * 512 + h * 128 + sl * 32);
#pragma unroll
                for (int c8 = 0; c8 < 4; ++c8) { const u32x4 u = vp[c8];
                    o[8 * c8 + 0] += pr * bflo(u.x); o[8 * c8 + 1] += pr * bfhi(u.x); o[8 * c8 + 2] += pr * bflo(u.y); o[8 * c8 + 3] += pr * bfhi(u.y);
                    o[8 * c8 + 4] += pr * bflo(u.z); o[8 * c8 + 5] += pr * bfhi(u.z); o[8 * c8 + 6] += pr * bflo(u.w); o[8 * c8 + 7] += pr * bfhi(u.w); }
            }
            const float il = 1.0f / l;
            if (mp == 0) {
#pragma unroll
                for (int e = 0; e < 32; ++e) o0[e] = o[e] * il;
            } else {
                float* dp = DIFF + rowq * 512 + h * 128 + sl * 32;
#pragma unroll
                for (int e = 0; e < 32; e += 4) *(f32x4*)(dp + e) = (f32x4){o0[e] - lam * o[e] * il, o0[e + 1] - lam * o[e + 1] * il, o0[e + 2] - lam * o[e + 2] * il, o0[e + 3] - lam * o[e + 3] * il};
            }
        }
    }
}

__device__ void phase_gla_naive(const Params& p, float* GO, int bid, int nb) {
    const bf16_t* GQ = (const bf16_t*)(p.ws + WS_GQ); const bf16_t* GK = (const bf16_t*)(p.ws + WS_GK); const bf16_t* GV = (const bf16_t*)(p.ws + WS_GV);
    const float* GLOG = (const float*)(p.ws + WS_GLOG);
    for (int w = bid * blockDim.x + threadIdx.x; w < BATCH * NH * 128; w += nb * blockDim.x) {
        const int dv = w & 127, bh = w >> 7, b = bh >> 2, h = bh & 3;
        float s[64];
#pragma unroll
        for (int d = 0; d < 64; ++d) s[d] = 0.f;
        for (int t = 0; t < SEQ; ++t) {
            const size_t row = (size_t)b * SEQ + t;
            const float v = bf2f(GV[row * 512 + h * 128 + dv]);
            const u32x4* qp = (const u32x4*)(GQ + row * 256 + h * 64); const u32x4* kp = (const u32x4*)(GK + row * 256 + h * 64);
            const f32x4* gp = (const f32x4*)(GLOG + row * 256 + h * 64);
            float o = 0.f;
#pragma unroll
            for (int c8 = 0; c8 < 8; ++c8) {
                const u32x4 qu = qp[c8], ku = kp[c8]; const f32x4 g0 = gp[2 * c8], g1 = gp[2 * c8 + 1];
                const float qf[8] = {bflo(qu.x), bfhi(qu.x), bflo(qu.y), bfhi(qu.y), bflo(qu.z), bfhi(qu.z), bflo(qu.w), bfhi(qu.w)};
                const float kf[8] = {bflo(ku.x), bfhi(ku.x), bflo(ku.y), bfhi(ku.y), bflo(ku.z), bfhi(ku.z), bflo(ku.w), bfhi(ku.w)};
                const float gf[8] = {g0[0], g0[1], g0[2], g0[3], g1[0], g1[1], g1[2], g1[3]};
#pragma unroll
                for (int e = 0; e < 8; ++e) { const int d = 8 * c8 + e; s[d] = __expf(gf[e]) * s[d] + kf[e] * v; o += qf[e] * s[d]; }
            }
            GO[row * 512 + h * 128 + dv] = o;
        }
    }
}

__device__ void phase_mixprep(const Params& p, const float* DIFF, const float* GO, int bid, int nb) {
    bf16_t* MIX = (bf16_t*)(p.ws + WS_MIX); const bf16_t* GR = (const bf16_t*)(p.ws + WS_GR);
    const int lane = threadIdx.x & 63, wpb = blockDim.x >> 6, gw = bid * wpb + (threadIdx.x >> 6), ngw = nb * wpb;
    for (int m = gw; m < M; m += ngw) {
        const bool gla = lane >= 32; const int cb = 16 * (lane & 31);
        const float* src = (gla ? GO : DIFF) + (size_t)m * 512 + cb;
        float v[16]; float ss = 0.f;
#pragma unroll
        for (int e = 0; e < 16; e += 4) { const f32x4 t = *(const f32x4*)(src + e); v[e] = t[0]; v[e + 1] = t[1]; v[e + 2] = t[2]; v[e + 3] = t[3]; ss += (t[0] * t[0] + t[1] * t[1]) + (t[2] * t[2] + t[3] * t[3]); }
        ss += __shfl_xor(ss, 1); ss += __shfl_xor(ss, 2); ss += __shfl_xor(ss, 4);
        const float r = 1.0f / sqrtf(ss * (1.f / 128.f) + LN_EPS);
        const float* nw = (gla ? p.gla_norm_w : p.diff_norm_w) + (cb & 127);
        unsigned w[8];
#pragma unroll
        for (int e = 0; e < 16; e += 2) {
            float a = v[e] * r * nw[e], c = v[e + 1] * r * nw[e + 1];
            if (gla) { a *= bf2f(GR[(size_t)m * 512 + cb + e]); c *= bf2f(GR[(size_t)m * 512 + cb + e + 1]); }
            else { a *= (1.0f - LAMBDA_INIT); c *= (1.0f - LAMBDA_INIT); }
            w[e >> 1] = pk2(a, c);
        }
        u32x4* dst = (u32x4*)(MIX + (size_t)m * D + (gla ? 512 : 0) + cb);
        dst[0] = (u32x4){w[0], w[1], w[2], w[3]}; dst[1] = (u32x4){w[4], w[5], w[6], w[7]};
    }
}

__device__ void phase_convact(const Params& p, int half, int bid, int nb) {
    const bf16_t* UP = (const bf16_t*)(p.ws + WS_UPH); bf16_t* ACT = (bf16_t*)(p.ws + WS_ACTH);
    const int total = 8192 * (F / 4);
    for (int e = bid * blockDim.x + threadIdx.x; e < total; e += nb * blockDim.x) {
        const int t = e / (F / 4), j0 = (e % (F / 4)) * 4, s = (t + half * 8192) & (SEQ - 1);
        const int ca = 256 * (j0 >> 7) + (j0 & 127), cbb = ca + 128;
        float a[4], bq[4];
#pragma unroll
        for (int q = 0; q < 4; ++q) { a[q] = p.conv_b[j0 + q]; bq[q] = p.conv_b[F + j0 + q]; }
#pragma unroll
        for (int k = 0; k < 3; ++k) {
            const int dt = 2 - k;
            if (s - dt >= 0) {
                const u32x2 ua = *(const u32x2*)(UP + (size_t)(t - dt) * F2 + ca), ub = *(const u32x2*)(UP + (size_t)(t - dt) * F2 + cbb);
                const float xa[4] = {bflo(ua.x), bfhi(ua.x), bflo(ua.y), bfhi(ua.y)}, xb[4] = {bflo(ub.x), bfhi(ub.x), bflo(ub.y), bfhi(ub.y)};
#pragma unroll
                for (int q = 0; q < 4; ++q) { a[q] += p.conv_w[k * F2 + j0 + q] * xa[q]; bq[q] += p.conv_w[k * F2 + F + j0 + q] * xb[q]; }
            }
        }
        u32x2 w; w.x = pk2(silu_f(a[0]) * bq[0], silu_f(a[1]) * bq[1]); w.y = pk2(silu_f(a[2]) * bq[2], silu_f(a[3]) * bq[3]);
        *(u32x2*)(ACT + (size_t)t * F + j0) = w;
    }
}

constexpr int NPHASE = 16;
template <int PH> __device__ __forceinline__ void run_phase(const Params& p, float* smem, int bid, int nb) {
    float* DIFF = p.out; float* GO = p.out + (size_t)M * 512;
    if constexpr (PH == 0) { phase_ada(p, smem, bid, nb); phase_wprep(p, smem, bid, nb); phase_rope(p, bid, nb); }
    else if constexpr (PH == 1) phase_ln_in(p, bid, nb);
    else if constexpr (PH == 2) { EpiIn e{p.ws, p.b_gate}; gemm_simple((const bf16_t*)(p.ws + WS_XN), D, (const bf16_t*)(p.ws + WS_WIN), D, M, N_INX, D, e, bid, nb); }
    else if constexpr (PH == 3) { phase_gla_naive(p, GO, bid, nb); phase_attn_naive(p, DIFF, bid, nb); }
    else if constexpr (PH == 4) phase_mixprep(p, DIFF, GO, bid, nb);
    else if constexpr (PH == 5) { EpiOut e{&p}; gemm_simple((const bf16_t*)(p.ws + WS_MIX), D, (const bf16_t*)(p.ws + WS_WOUT), D, M, D, D, e, bid, nb); }
    else if constexpr (PH == 6) phase_ln_rows(p, p.out, p.ln_attn_g, p.ln_attn_b, (bf16_t*)(p.ws + WS_XN), 3072, 4096, bid, nb);
    else if constexpr (PH == 7 || PH == 10) { constexpr int half = (PH == 10); EpiUpRaw e{(bf16_t*)(p.ws + WS_UPH), 0};
        gemm_simple((const bf16_t*)(p.ws + WS_XN) + (size_t)half * 8192 * D, D, (const bf16_t*)(p.ws + WS_WUP), D, 8192, F2, D, e, bid, nb); }
    else if constexpr (PH == 8 || PH == 11) phase_convact(p, PH == 11, bid, nb);
    else if constexpr (PH == 9 || PH == 12) { constexpr int half = (PH == 12); EpiDown e{&p, half * 8192};
        gemm_simple((const bf16_t*)(p.ws + WS_ACTH), F, (const bf16_t*)(p.ws + WS_WDOWN), F, 8192, D, F, e, bid, nb); }
    else if constexpr (PH == 13) phase_ln_rows(p, p.out, p.ln_ffn_g, p.ln_ffn_b, nullptr, 0, 0, bid, nb);
}
constexpr int LAST_PHASE = 13;

constexpr int NTHREADS = 256;
constexpr int SMEM_FLOATS = 64 * 65 > 32 * 32 * 4 ? 64 * 65 : 32 * 32 * 4;

template <int PH> __global__ void __launch_bounds__(NTHREADS) k_phase(Params p) {
    __shared__ float smem[SMEM_FLOATS];
    run_phase<PH>(p, smem, blockIdx.x, gridDim.x);
}
template <int PH> struct PhaseLoop { static __device__ __forceinline__ void run(const Params& p, float* smem, cg::grid_group& grid) {
    run_phase<PH>(p, smem, blockIdx.x, gridDim.x);
    if constexpr (PH < LAST_PHASE) { grid.sync(); PhaseLoop<PH + 1>::run(p, smem, grid); } } };
__global__ void __launch_bounds__(NTHREADS) k_mega(Params p) {
    __shared__ float smem[SMEM_FLOATS];
    cg::grid_group grid = cg::this_grid();
    PhaseLoop<0>::run(p, smem, grid);
}

template <int PH> static void launch_phases(const Params& p, int grid, hipStream_t stream) {
    hipLaunchKernelGGL(k_phase<PH>, dim3(grid), dim3(NTHREADS), 0, stream, p);
    if constexpr (PH < LAST_PHASE) launch_phases<PH + 1>(p, grid, stream);
}

extern "C" void kernel_launch(void* const* d_in, const int* in_sizes, int n_in, void* d_out, int out_size, void* d_ws, size_t ws_size, hipStream_t stream) {
    if (n_in != 25 || in_sizes[0] != M * D || out_size != M * D || ws_size < WS_END) {
        fprintf(stderr, "kernel_launch: unexpected shapes (n_in %d, in0 %d, out %d, ws %zu)\n", n_in, n_in > 0 ? in_sizes[0] : -1, out_size, ws_size); return; }
    Params p{};
    p.x = (const float*)d_in[0]; p.c = (const float*)d_in[1]; p.pos = (const int*)d_in[2]; p.ln_in_g = (const float*)d_in[3]; p.ln_in_b = (const float*)d_in[4];
    p.w_ada = (const float*)d_in[5]; p.b_ada = (const float*)d_in[6]; p.w_in = (const float*)d_in[7];
    p.lq1 = (const float*)d_in[8]; p.lk1 = (const float*)d_in[9]; p.lq2 = (const float*)d_in[10]; p.lk2 = (const float*)d_in[11];
    p.diff_norm_w = (const float*)d_in[12]; p.w_gate_up = (const float*)d_in[13]; p.b_gate = (const float*)d_in[14]; p.gla_norm_w = (const float*)d_in[15];
    p.w_out = (const float*)d_in[16]; p.ln_attn_g = (const float*)d_in[17]; p.ln_attn_b = (const float*)d_in[18];
    p.w_up = (const float*)d_in[19]; p.conv_w = (const float*)d_in[20]; p.conv_b = (const float*)d_in[21]; p.w_down = (const float*)d_in[22];
    p.ln_ffn_g = (const float*)d_in[23]; p.ln_ffn_b = (const float*)d_in[24];
    p.out = (float*)d_out; p.ws = (unsigned char*)d_ws;
#if ONE_LAUNCH
    static int grid_blocks = 0;
    if (!grid_blocks) {
        int dev = 0, cus = 0, per_cu = 0;
        hipGetDevice(&dev); hipDeviceGetAttribute(&cus, hipDeviceAttributeMultiprocessorCount, dev);
        hipOccupancyMaxActiveBlocksPerMultiprocessor(&per_cu, (const void*)k_mega, NTHREADS, 0);
        if (per_cu > 4) per_cu = 4;
        if (per_cu < 1) per_cu = 1;
        grid_blocks = cus * per_cu;
    }
    void* args[] = {&p};
    hipError_t e = hipLaunchCooperativeKernel((const void*)k_mega, dim3(grid_blocks), dim3(NTHREADS), args, 0, stream);
    if (e != hipSuccess) fprintf(stderr, "cooperative launch failed: %s (grid %d)\n", hipGetErrorString(e), grid_blocks);
#else
    launch_phases<0>(p, 2048, stream);
#endif
}
```

```cpp
#include <hip/hip_runtime.h>
#include <stdint.h>
#include <stdio.h>

#ifndef ONE_LAUNCH
#define ONE_LAUNCH 1
#endif

typedef unsigned short bf16_t;
typedef short bf16x8 __attribute__((ext_vector_type(8)));
typedef float f32x4 __attribute__((ext_vector_type(4)));
typedef unsigned u32x4 __attribute__((ext_vector_type(4)));
typedef unsigned u32x2 __attribute__((ext_vector_type(2)));

constexpr int D = 1024, BATCH = 4, SEQ = 4096, M = BATCH * SEQ;
constexpr int NH = 4;
constexpr int N_INX = 3328;
constexpr int F = 2816, F2 = 5632;
constexpr float LN_EPS = 1e-5f;
constexpr float DN_ALPHA = 1.189207115002721f;
constexpr float LAMBDA_INIT = 0.2f;
constexpr float QSCALE = 0.125f * 1.4426950408889634f;

constexpr size_t MiB = 1u << 20;
constexpr size_t WS_CTL = 0;
constexpr size_t WS_ADA = 1 * MiB;
constexpr size_t WS_STATS = 1 * MiB + 256 * 1024;
constexpr size_t WS_COS = 2 * MiB, WS_SIN = 4 * MiB;
constexpr size_t WS_WIN = 6 * MiB;
constexpr size_t WS_WOUT = 13 * MiB;
constexpr size_t WS_WUP = 15 * MiB;
constexpr size_t WS_WDOWN = 26 * MiB;
constexpr size_t WS_XN = 32 * MiB + 4096;
constexpr size_t WS_BIG = 65 * MiB;
constexpr size_t WS_DQ = WS_BIG, WS_DK = WS_BIG + 16 * MiB, WS_DV = WS_BIG + 32 * MiB;
constexpr size_t WS_GQ = WS_BIG + 48 * MiB, WS_GK = WS_BIG + 56 * MiB;
constexpr size_t WS_GV = WS_BIG + 64 * MiB, WS_GR = WS_BIG + 80 * MiB;
constexpr size_t WS_GLOG = WS_BIG + 96 * MiB;
constexpr size_t WS_MIX = WS_BIG + 112 * MiB;
constexpr size_t WS_GLU = WS_BIG + 144 * MiB;
constexpr size_t WS_UPH = WS_BIG;
constexpr size_t WS_ACTH = WS_BIG + 88 * MiB;
constexpr size_t WS_END = 256 * MiB;

struct Params {
    const float* x; const float* c; const int* pos; const float* ln_in_g; const float* ln_in_b;
    const float* w_ada; const float* b_ada; const float* w_in;
    const float* lq1; const float* lk1; const float* lq2; const float* lk2;
    const float* diff_norm_w; const float* w_gate_up; const float* b_gate; const float* gla_norm_w;
    const float* w_out; const float* ln_attn_g; const float* ln_attn_b;
    const float* w_up; const float* conv_w; const float* conv_b; const float* w_down;
    const float* ln_ffn_g; const float* ln_ffn_b;
    float* out; unsigned char* ws;
};

__device__ __forceinline__ unsigned f2bf(float f) { unsigned u = __builtin_bit_cast(unsigned, f); return (u + 0x7fffu + ((u >> 16) & 1u)) >> 16; }
__device__ __forceinline__ unsigned pk2(float lo, float hi) { return f2bf(lo) | (f2bf(hi) << 16); }
typedef float f32x2_t __attribute__((ext_vector_type(2)));
typedef __bf16 bf16x2_t __attribute__((ext_vector_type(2)));
__device__ __forceinline__ unsigned cvtpk(float lo, float hi) { f32x2_t v = {lo, hi}; bf16x2_t b = __builtin_convertvector(v, bf16x2_t); return __builtin_bit_cast(unsigned, b); }
__device__ __forceinline__ float bf2f(unsigned short b) { return __builtin_bit_cast(float, (unsigned)b << 16); }
__device__ __forceinline__ float bflo(unsigned w) { return __builtin_bit_cast(float, w << 16); }
__device__ __forceinline__ float bfhi(unsigned w) { return __builtin_bit_cast(float, w & 0xffff0000u); }
__device__ __forceinline__ float wave_sum(float v) {
#pragma unroll
    for (int o = 1; o < 64; o <<= 1) v += __shfl_xor(v, o);
    return v;
}
__device__ __forceinline__ float silu_f(float v) { return v / (1.0f + __expf(-v)); }
__device__ __forceinline__ float lambda_full(const Params& p) {
    float s1 = 0.f, s2 = 0.f;
    for (int i = 0; i < 64; ++i) { s1 += p.lq1[i] * p.lk1[i]; s2 += p.lq2[i] * p.lk2[i]; }
    return expf(s1) - expf(s2) + LAMBDA_INIT;
}

__device__ void phase_ada(const Params& p, float* smem, int bid, int nb) {
    float* ada = (float*)(p.ws + WS_ADA);
    const int t = threadIdx.x, nt = blockDim.x, cgp = t & 7, kl = t >> 3, nkl = nt >> 3;
    for (int item = bid; item < 6144 / 32; item += nb) {
        const int n0 = item * 32;
        float acc[4][4];
#pragma unroll
        for (int b = 0; b < 4; ++b)
#pragma unroll
            for (int j = 0; j < 4; ++j) acc[b][j] = 0.f;
        for (int k = kl; k < D; k += nkl) {
            const f32x4 w = *(const f32x4*)(p.w_ada + (size_t)k * 6144 + n0 + 4 * cgp);
#pragma unroll
            for (int b = 0; b < 4; ++b) { const float ca = silu_f(p.c[b * D + k]);
#pragma unroll
                for (int j = 0; j < 4; ++j) acc[b][j] += ca * w[j]; }
        }
        __syncthreads();
#pragma unroll
        for (int b = 0; b < 4; ++b)
#pragma unroll
            for (int j = 0; j < 4; ++j) smem[(kl * 32 + 4 * cgp + j) * 4 + b] = acc[b][j];
        __syncthreads();
        if (t < 128) { const int col = t & 31, b = t >> 5; float s = 0.f;
            for (int q = 0; q < nkl; ++q) s += smem[(q * 32 + col) * 4 + b];
            ada[b * 6144 + n0 + col] = s + p.b_ada[n0 + col]; }
    }
}

__device__ __forceinline__ void wprep_tile(const Params& p, float* tile  , int kind, int tn, int tk) {
    const int t = threadIdx.x, nt = blockDim.x, tx = t & 63, ty = t >> 6, nty = nt >> 6;
    const float* W; int N, K; bf16_t* WT;
    if (kind == 0) { W = p.w_in; N = 3088; K = D; WT = (bf16_t*)(p.ws + WS_WIN); }
    else if (kind == 1) { W = p.w_out; N = D; K = D; WT = (bf16_t*)(p.ws + WS_WOUT); }
    else if (kind == 2) { W = p.w_up; N = F2; K = D; WT = (bf16_t*)(p.ws + WS_WUP); }
    else { W = p.w_down; N = D; K = F; WT = (bf16_t*)(p.ws + WS_WDOWN); }
    const int n0 = tn * 64, k0 = tk * 64, np = n0 + tx;
    __syncthreads();
    if (kind == 0 && n0 >= 3072) {
        const int j = np - 3072;
        float g[16];
#pragma unroll
        for (int r = 0; r < 16; ++r) g[r] = p.w_gate_up[r * 256 + j];
        for (int kk = ty; kk < 64; kk += nty) { const float* wr = W + (size_t)(k0 + kk) * N + 3072; float s = 0.f;
#pragma unroll
            for (int r = 0; r < 16; ++r) s += wr[r] * g[r];
            tile[kk * 65 + tx] = s; }
    } else {
        int src;
        if (kind == 0) { if (np < 1024) { const int pp = np & 63; src = (np & ~63) + (pp >> 1) + 32 * (pp & 1); } else src = np; }
        else if (kind == 2) { const int pn = np >> 8, w = np & 255; src = (w < 128) ? (128 * pn + w) : (F + 128 * pn + (w - 128)); }
        else src = np;
        for (int kk = ty; kk < 64; kk += nty) tile[kk * 65 + tx] = W[(size_t)(k0 + kk) * N + src];
    }
    __syncthreads();
    for (int nn = ty; nn < 64; nn += nty) WT[(size_t)(n0 + nn) * K + k0 + tx] = (bf16_t)f2bf(tile[tx * 65 + nn]);
}
__device__ void phase_wprep(const Params& p, float* smem, int bid, int nb) {
    constexpr int T0 = (N_INX / 64) * (D / 64), T1 = (D / 64) * (D / 64), T2 = (F2 / 64) * (D / 64), T3 = (D / 64) * (F / 64);
    for (int it = bid; it < T0 + T1 + T2 + T3; it += nb) {
        int r = it;
        if (r < T0) { wprep_tile(p, smem, 0, r / (D / 64), r % (D / 64)); continue; } r -= T0;
        if (r < T1) { wprep_tile(p, smem, 1, r / (D / 64), r % (D / 64)); continue; } r -= T1;
        if (r < T2) { wprep_tile(p, smem, 2, r / (D / 64), r % (D / 64)); continue; } r -= T2;
        wprep_tile(p, smem, 3, r / (F / 64), r % (F / 64));
    }
}

__device__ void phase_rope(const Params& p, int bid, int nb) {
    float* COS = (float*)(p.ws + WS_COS); float* SIN = (float*)(p.ws + WS_SIN);
    for (int e = bid * blockDim.x + threadIdx.x; e < M * 32; e += nb * blockDim.x) {
        const int m = e >> 5, i = e & 31;
        double inv = 1.0; const double r = 0.74989420933245582730;
        for (int q = 0; q < i; ++q) inv *= r;
        const float invf = (float)inv;
        const double a = (double)((float)p.pos[m] * invf);
        const double qd = __builtin_rint(a * 0.63661977236758134308);
        const double rr = __builtin_fma(-qd, 1.57079632679489661923, a);
        const float x = (float)rr, x2 = x * x;
        const float s = x * (1.f + x2 * (-1.f / 6.f + x2 * (1.f / 120.f + x2 * (-1.f / 5040.f + x2 * (1.f / 362880.f)))));
        const float cc = 1.f + x2 * (-0.5f + x2 * (1.f / 24.f + x2 * (-1.f / 720.f + x2 * (1.f / 40320.f + x2 * (-1.f / 3628800.f)))));
        const int qi = (int)((long long)qd & 3);
        float co, si;
        if (qi == 0) { co = cc; si = s; } else if (qi == 1) { co = -s; si = cc; } else if (qi == 2) { co = -cc; si = -s; } else { co = s; si = -cc; }
        COS[e] = co; SIN[e] = si;
    }
}

__device__ __forceinline__ void ln_stats(const f32x4 (&v)[4], float& mean, float& rstd) {
    float s = 0.f;
#pragma unroll
    for (int j = 0; j < 4; ++j) s += (v[j].x + v[j].y) + (v[j].z + v[j].w);
    mean = wave_sum(s) * (1.f / D); float s2 = 0.f;
#pragma unroll
    for (int j = 0; j < 4; ++j) { const f32x4 d = v[j] - mean; s2 += (d.x * d.x + d.y * d.y) + (d.z * d.z + d.w * d.w); }
    rstd = 1.0f / sqrtf(wave_sum(s2) * (1.f / D) + LN_EPS);
}
__device__ void phase_ln_in(const Params& p, int bid, int nb) {
    const float* ada = (const float*)(p.ws + WS_ADA); float* stats = (float*)(p.ws + WS_STATS); bf16_t* XN = (bf16_t*)(p.ws + WS_XN);
    const int lane = threadIdx.x & 63, wpb = blockDim.x >> 6, gw = bid * wpb + (threadIdx.x >> 6), ngw = nb * wpb;
    for (int m = gw; m < M; m += ngw) {
        const int b = m / SEQ;
        const f32x4* xr = (const f32x4*)(p.x + (size_t)m * D) + lane;
        f32x4 v[4];
#pragma unroll
        for (int j = 0; j < 4; ++j) v[j] = xr[64 * j];
        float mean, rstd; ln_stats(v, mean, rstd);
        if (lane == 0) { stats[2 * m] = mean; stats[2 * m + 1] = rstd; }
        u32x2* o8 = (u32x2*)(XN + (size_t)m * D) + lane;
#pragma unroll
        for (int j = 0; j < 4; ++j) {
            const int col = 4 * lane + 256 * j;
            const f32x4 g = *(const f32x4*)(p.ln_in_g + col), bb = *(const f32x4*)(p.ln_in_b + col);
            const f32x4 sh = *(const f32x4*)(ada + b * 6144 + col), sc = *(const f32x4*)(ada + b * 6144 + 1024 + col);
            const f32x4 h = (v[j] - mean) * rstd * g + bb;
            const f32x4 u = h * (1.0f + sc) + sh;
            u32x2 w; w.x = pk2(u.x, u.y); w.y = pk2(u.z, u.w); o8[64 * j] = w;
        }
    }
}
__device__ void phase_ln_rows(const Params& p, float* R, const float* g, const float* bb, bf16_t* XN2, int sh_off, int sc_off, int bid, int nb) {
    const float* ada = (const float*)(p.ws + WS_ADA);
    const int lane = threadIdx.x & 63, wpb = blockDim.x >> 6, gw = bid * wpb + (threadIdx.x >> 6), ngw = nb * wpb;
    for (int m = gw; m < M; m += ngw) {
        const int b = m / SEQ;
        f32x4* xr = (f32x4*)(R + (size_t)m * D) + lane;
        f32x4 v[4];
#pragma unroll
        for (int j = 0; j < 4; ++j) v[j] = xr[64 * j];
        float mean, rstd; ln_stats(v, mean, rstd);
#pragma unroll
        for (int j = 0; j < 4; ++j) {
            const int col = 4 * lane + 256 * j;
            const f32x4 gg = *(const f32x4*)(g + col), b4 = *(const f32x4*)(bb + col);
            const f32x4 h = (v[j] - mean) * rstd * gg + b4;
            xr[64 * j] = h;
            if (XN2) {
                const f32x4 sh = *(const f32x4*)(ada + b * 6144 + sh_off + col), sc = *(const f32x4*)(ada + b * 6144 + sc_off + col);
                const f32x4 u = h * (1.0f + sc) + sh;
                u32x2 w; w.x = pk2(u.x, u.y); w.y = pk2(u.z, u.w); ((u32x2*)(XN2 + (size_t)m * D) + lane)[64 * j] = w;
            }
        }
    }
}

template <class Epi>
__device__ void gemm_simple(const bf16_t* A, int lda, const bf16_t* Bt, int ldb, int Mrows, int N, int K, const Epi& epi, int bid, int nb) {
    const int lane = threadIdx.x & 63, fr = lane & 15, fq = lane >> 4, wpb = blockDim.x >> 6, gw = bid * wpb + (threadIdx.x >> 6), ngw = nb * wpb;
    const int ntn = N / 32, ntiles = (Mrows / 32) * ntn;
    for (int tile = gw; tile < ntiles; tile += ngw) {
        const int m0 = (tile / ntn) * 32, n0 = (tile % ntn) * 32;
        f32x4 acc[2][2];
#pragma unroll
        for (int i = 0; i < 2; ++i)
#pragma unroll
            for (int j = 0; j < 2; ++j) acc[i][j] = (f32x4){0.f, 0.f, 0.f, 0.f};
        const bf16_t* ap = A + (size_t)(m0 + fr) * lda + 8 * fq;
        const bf16_t* bp = Bt + (size_t)(n0 + fr) * ldb + 8 * fq;
#pragma unroll 4
        for (int k0 = 0; k0 < K; k0 += 32) {
            bf16x8 a[2], b[2];
            a[0] = *(const bf16x8*)(ap + k0); a[1] = *(const bf16x8*)(ap + (size_t)16 * lda + k0);
            b[0] = *(const bf16x8*)(bp + k0); b[1] = *(const bf16x8*)(bp + (size_t)16 * ldb + k0);
#pragma unroll
            for (int i = 0; i < 2; ++i)
#pragma unroll
                for (int j = 0; j < 2; ++j) acc[i][j] = __builtin_amdgcn_mfma_f32_16x16x32_bf16(b[j], a[i], acc[i][j], 0, 0, 0);
        }
#pragma unroll
        for (int i = 0; i < 2; ++i)
#pragma unroll
            for (int j = 0; j < 2; ++j) epi(m0 + 16 * i + fr, n0 + 16 * j + 4 * fq, acc[i][j]);
    }
}

struct EpiIn {
    unsigned char* ws; const float* b_gate;
    __device__ __forceinline__ void operator()(int row, int col0, f32x4 v) const {
        if (col0 < 1024) {
            const int i0 = (col0 & 63) >> 1;
            const float* COS = (const float*)(ws + WS_COS) + (size_t)row * 32 + i0; const float* SIN = (const float*)(ws + WS_SIN) + (size_t)row * 32 + i0;
            const float c0 = COS[0], c1 = COS[1], s0 = SIN[0], s1 = SIN[1];
            float o0 = v[0] * c0 - v[1] * s0, o1 = v[1] * c0 + v[0] * s0, o2 = v[2] * c1 - v[3] * s1, o3 = v[3] * c1 + v[2] * s1;
            bf16_t* dst;
            if (col0 < 512) { o0 *= QSCALE; o1 *= QSCALE; o2 *= QSCALE; o3 *= QSCALE; dst = (bf16_t*)(ws + WS_DQ) + (size_t)row * 512 + col0; }
            else dst = (bf16_t*)(ws + WS_DK) + (size_t)row * 512 + (col0 - 512);
            u32x2 w; w.x = pk2(o0, o1); w.y = pk2(o2, o3); *(u32x2*)dst = w;
        } else if (col0 < 3072) {
            bf16_t* dst;
            if (col0 < 1536) dst = (bf16_t*)(ws + WS_DV) + (size_t)row * 512 + (col0 - 1024);
            else if (col0 < 1792) { v = v * 0.125f; dst = (bf16_t*)(ws + WS_GQ) + (size_t)row * 256 + (col0 - 1536); }
            else if (col0 < 2048) dst = (bf16_t*)(ws + WS_GK) + (size_t)row * 256 + (col0 - 1792);
            else if (col0 < 2560) dst = (bf16_t*)(ws + WS_GV) + (size_t)row * 512 + (col0 - 2048);
            else { v = (f32x4){silu_f(v[0]), silu_f(v[1]), silu_f(v[2]), silu_f(v[3])}; dst = (bf16_t*)(ws + WS_GR) + (size_t)row * 512 + (col0 - 2560); }
            u32x2 w; w.x = pk2(v[0], v[1]); w.y = pk2(v[2], v[3]); *(u32x2*)dst = w;
        } else {
            const int j = col0 - 3072; f32x4 o;
#pragma unroll
            for (int q = 0; q < 4; ++q) { const float z = v[q] + b_gate[j + q]; o[q] = (fminf(z, 0.f) - __logf(1.0f + __expf(-fabsf(z)))) * (1.0f / 16.0f); }
            *(f32x4*)((float*)(ws + WS_GLOG) + (size_t)row * 256 + j) = o;
        }
    }
};
struct EpiOut {
    const Params* p;
    __device__ __forceinline__ void operator()(int row, int col0, f32x4 v) const {
        const float* ada = (const float*)(p->ws + WS_ADA); const float* stats = (const float*)(p->ws + WS_STATS);
        const int b = row / SEQ; const float mean = stats[2 * row], rstd = stats[2 * row + 1];
        const f32x4 xv = *(const f32x4*)(p->x + (size_t)row * D + col0), g = *(const f32x4*)(p->ln_in_g + col0), bb = *(const f32x4*)(p->ln_in_b + col0);
        const f32x4 gt = *(const f32x4*)(ada + b * 6144 + 2048 + col0);
        const f32x4 h0 = (xv - mean) * rstd * g + bb;
        *(f32x4*)(p->out + (size_t)row * D + col0) = h0 * DN_ALPHA + (1.0f + gt) * v;
    }
};
struct EpiUpRaw {
    bf16_t* UP; int row_off;
    __device__ __forceinline__ void operator()(int row, int col0, f32x4 v) const {
        u32x2 w; w.x = pk2(v[0], v[1]); w.y = pk2(v[2], v[3]); *(u32x2*)(UP + (size_t)row * F2 + col0) = w;
    }
};
struct EpiDown {
    const Params* p; int row_off;
    __device__ __forceinline__ void operator()(int row, int col0, f32x4 v) const {
        const float* ada = (const float*)(p->ws + WS_ADA);
        const int grow = row + row_off, b = grow / SEQ;
        const f32x4 gt = *(const f32x4*)(ada + b * 6144 + 5120 + col0);
        f32x4* o = (f32x4*)(p->out + (size_t)grow * D + col0);
        *o = (*o) * DN_ALPHA + (1.0f + gt) * v;
    }
};


namespace pg8 {
#define PG8_LAS __attribute__((address_space(3)))
typedef unsigned short bf16_t;
typedef short bf16x8 __attribute__((ext_vector_type(8)));
typedef float f32x4 __attribute__((ext_vector_type(4)));
typedef unsigned u32x4 __attribute__((ext_vector_type(4)));
constexpr int BM = 256, BK = 64, HALF = 128, HTB = HALF * BK * 2  , STAGE_BYTES = 8 * HTB, NXCD = 8, WGM = 8;

__host__ __device__ __forceinline__ int lds_byte(int r, int c) { const int st = (r >> 4) * 2 + (c >> 5), rr = r & 15, cc = c & 31, ob = rr * 64 + cc * 2; return st * 1024 + (ob ^ (((ob >> 9) & 1) << 5)); }
__host__ __device__ __forceinline__ void stage_rc(int b, int& R, int& C) { const int st = b / 1024, sb = b % 1024, swz = sb ^ (((sb >> 9) & 1) << 5); R = (st >> 1) * 16 + swz / 64; C = (st & 1) * 32 + (swz % 64) / 2; }
__host__ __device__ __forceinline__ int perm32(int rho) { const int n = rho >> 4, i = rho & 15; return 8 * (i >> 2) + 4 * n + (i & 3); }

struct Unit { int pm, pn; };
struct Gemm { const bf16_t* A; const bf16_t* Bt; int M, N, K; };

struct StaticOrder {
    int nM, nN, nwg, G, c;
    __host__ __device__ void init(int M, int N, int G_, int c_) { nM = M / BM; nN = N / BM; nwg = nM * nN; G = G_; c = c_; }
    __host__ __device__ bool next(int i, Unit& u) const {
        const long L = (long)i * G + c; if (L >= nwg) return false;
        int wgid = (int)L; { const int q = nwg / NXCD, r = nwg % NXCD, xcd = wgid % NXCD, off = wgid / NXCD; wgid = (xcd < r ? xcd * (q + 1) : r * (q + 1) + (xcd - r) * q) + off; }
        const int nig = WGM * nN, gid = wgid / nig, fm = gid * WGM, gsz = (nM - fm) < WGM ? (nM - fm) : WGM;
        u.pm = fm + ((wgid % nig) % gsz); u.pn = (wgid % nig) / gsz; return true;
    }
    __device__ __forceinline__ void a_ready(const Unit&) const {}
    __device__ __forceinline__ void done(const Unit&) const {}
};
__device__ __forceinline__ unsigned cvt_pk_bf16(float lo, float hi) { unsigned r; asm volatile("v_cvt_pk_bf16_f32 %0, %1, %2" : "=v"(r) : "v"(lo), "v"(hi)); return r; }
template <class Epi, class Sched, bool ALIGN_EPI = false, bool SP2 = false>
__device__ __forceinline__ void gemm_phase(PG8_LAS unsigned char* lds, const Gemm g, const Sched& S, const Epi& E) {
    int tid_ = threadIdx.x; asm volatile("" : "+v"(tid_));
    const int tid = tid_, wid = __builtin_amdgcn_readfirstlane(tid >> 6), lane = tid & 63, wr = wid >> 2, wc = wid & 3, fr = lane & 15, fq = lane >> 4;
    const int K = g.K, nt = K / BK;
    unsigned voffA[2], voffB[2];
#pragma unroll
    for (int i = 0; i < 2; ++i) { int R, C; stage_rc(tid * 16 + i * 8192, R, C); const int Rb = Epi::PERM ? ((R & ~31) + perm32(R & 31)) : R;
        voffA[i] = (unsigned)(R * K + C) * 2u; voffB[i] = (unsigned)(Rb * K + C) * 2u; }
    const size_t kstep = (size_t)(BK * 2);
    const size_t hstep = (size_t)HALF * K * 2;
    const size_t tstep = 2 * hstep;
    const unsigned ldsw = (unsigned)wid * 1024u;
    const int aoff = lds_byte(wr * 64 + fr, fq * 8), boff = lds_byte(wc * 32 + fr, fq * 8);
#define PG8_SA(b, h) (((b) * 2 + (h)) * HTB)
#define PG8_SB(b, h) ((4 + (b) * 2 + (h)) * HTB)
#define PG8_STAGE(bufoff, gbase, voff) do { _Pragma("unroll") for (int _i = 0; _i < 2; ++_i) \
        __builtin_amdgcn_global_load_lds((const unsigned*)((const char*)(gbase) + (voff)[_i]), (PG8_LAS unsigned*)(lds + (bufoff) + ldsw + _i * 8192), 16, 0, 0); } while (0)
#define PG8_LDA(dst, b, h) do { _Pragma("unroll") for (int m = 0; m < 4; ++m) _Pragma("unroll") for (int k = 0; k < 2; ++k) dst[m][k] = *(const PG8_LAS bf16x8*)(lds + PG8_SA(b, h) + aoff + m * 2048 + k * 1024); } while (0)
#define PG8_LDB(dst, b, h) do { _Pragma("unroll") for (int n = 0; n < 2; ++n) _Pragma("unroll") for (int k = 0; k < 2; ++k) dst[n][k] = *(const PG8_LAS bf16x8*)(lds + PG8_SB(b, h) + boff + n * 2048 + k * 1024); } while (0)
#define PG8_MMA(ai, bj, At, Bt) do { __builtin_amdgcn_s_setprio(1); _Pragma("unroll") for (int m = 0; m < 4; ++m) _Pragma("unroll") for (int n = 0; n < 2; ++n) _Pragma("unroll") for (int k = 0; k < 2; ++k) \
        acc[ai][bj][m][n] = __builtin_amdgcn_mfma_f32_16x16x32_bf16(Bt[n][k], At[m][k], acc[ai][bj][m][n], 0, 0, 0); __builtin_amdgcn_s_setprio(0); } while (0)
#define PG8_WAIT_V(n) asm volatile("s_waitcnt vmcnt(" #n ")" ::: "memory")
#define PG8_WAIT_L(n) asm volatile("s_waitcnt lgkmcnt(" #n ")" ::: "memory")
#define PG8_BAR __builtin_amdgcn_s_barrier()
#define PG8_SCHED __builtin_amdgcn_sched_barrier(0)
    Unit cur, nxt; int ui = 0;
    if (!S.next(0, cur)) return;
    f32x4 acc[2][2][4][2];
#pragma unroll
    for (int a = 0; a < 2; ++a)
#pragma unroll
        for (int b = 0; b < 2; ++b)
#pragma unroll
            for (int m = 0; m < 4; ++m)
#pragma unroll
                for (int n = 0; n < 2; ++n) acc[a][b][m][n] = (f32x4){0.f, 0.f, 0.f, 0.f};
    bf16x8 At[4][2], B0[2][2], B1[2][2];
    const char* cA = (const char*)g.A + (size_t)cur.pm * tstep; const char* cB = (const char*)g.Bt + (size_t)cur.pn * tstep;
    S.a_ready(cur);
    if constexpr (SP2) {
        PG8_STAGE(PG8_SB(0, 0), cB, voffB); PG8_STAGE(PG8_SB(0, 1), cB + hstep, voffB); PG8_STAGE(PG8_SA(0, 0), cA, voffA); PG8_STAGE(PG8_SA(0, 1), cA + hstep, voffA);
        if (wr == 1) PG8_BAR;
        PG8_WAIT_V(2); PG8_BAR;
        PG8_STAGE(PG8_SB(1, 0), cB + kstep, voffB); PG8_STAGE(PG8_SA(1, 0), cA + kstep, voffA); PG8_STAGE(PG8_SB(1, 1), cB + hstep + kstep, voffB);
        PG8_WAIT_V(6); PG8_BAR;
    } else {
        PG8_STAGE(PG8_SB(0, 0), cB, voffB); PG8_STAGE(PG8_SA(0, 0), cA, voffA); PG8_STAGE(PG8_SB(0, 1), cB + hstep, voffB); PG8_STAGE(PG8_SA(0, 1), cA + hstep, voffA);
        if (wr == 1) PG8_BAR;
        PG8_WAIT_V(4); PG8_BAR;
        PG8_STAGE(PG8_SB(1, 0), cB + kstep, voffB); PG8_STAGE(PG8_SA(1, 0), cA + kstep, voffA); PG8_STAGE(PG8_SB(1, 1), cB + hstep + kstep, voffB);
        PG8_WAIT_V(6); PG8_BAR;
    }
    for (;;) {
        const bool has_next = S.next(ui + 1, nxt);
        const char* nA = has_next ? (const char*)g.A + (size_t)nxt.pm * tstep : cA; const char* nB = has_next ? (const char*)g.Bt + (size_t)nxt.pn * tstep : cB;
        for (int t = 0; t < nt; t += 2) {
            const bool last = (t == nt - 2);
            const char* a1 = cA + (size_t)(t + 1) * kstep;
            const char* a2 = last ? nA : cA + (size_t)(t + 2) * kstep; const char* b2 = last ? nB : cB + (size_t)(t + 2) * kstep;
            const char* a3 = a2 + kstep; const char* b3 = b2 + kstep;
            if (last && has_next) S.a_ready(nxt);
            if constexpr (SP2) {
            PG8_LDB(B0, 0, 0); PG8_LDB(B1, 0, 1); PG8_SCHED; PG8_LDA(At, 0, 0); PG8_STAGE(PG8_SA(1, 1), a1 + hstep, voffA);
            PG8_WAIT_V(8); PG8_WAIT_L(0); PG8_BAR; PG8_MMA(0, 0, At, B0); PG8_MMA(0, 1, At, B1); PG8_BAR; PG8_SCHED;
            PG8_LDA(At, 0, 1); PG8_STAGE(PG8_SB(0, 0), b2, voffB); PG8_STAGE(PG8_SB(0, 1), b2 + hstep, voffB); PG8_STAGE(PG8_SA(0, 0), a2, voffA);
            PG8_WAIT_V(8); PG8_WAIT_L(0); PG8_BAR; PG8_MMA(1, 0, At, B0); PG8_MMA(1, 1, At, B1); PG8_BAR; PG8_SCHED;
            PG8_LDB(B0, 1, 0); PG8_LDB(B1, 1, 1); PG8_SCHED; PG8_LDA(At, 1, 0); PG8_STAGE(PG8_SA(0, 1), a2 + hstep, voffA);
            PG8_WAIT_V(8); PG8_WAIT_L(0); PG8_BAR; PG8_MMA(0, 0, At, B0); PG8_MMA(0, 1, At, B1); PG8_BAR; PG8_SCHED;
            PG8_LDA(At, 1, 1); PG8_STAGE(PG8_SB(1, 0), b3, voffB); PG8_STAGE(PG8_SB(1, 1), b3 + hstep, voffB); PG8_STAGE(PG8_SA(1, 0), a3, voffA);
            PG8_WAIT_V(8); PG8_WAIT_L(0); PG8_BAR; PG8_MMA(1, 0, At, B0); PG8_MMA(1, 1, At, B1); PG8_BAR; PG8_SCHED;
            } else {
            PG8_LDB(B0, 0, 0); PG8_SCHED; PG8_LDA(At, 0, 0); PG8_STAGE(PG8_SA(1, 1), a1 + hstep, voffA);
            PG8_WAIT_L(8); PG8_BAR; PG8_WAIT_L(0); PG8_MMA(0, 0, At, B0); PG8_BAR; PG8_SCHED;
            PG8_LDB(B1, 0, 1); PG8_STAGE(PG8_SB(0, 0), b2, voffB);
            PG8_BAR; PG8_WAIT_L(0); PG8_MMA(0, 1, At, B1); PG8_BAR;
            PG8_LDA(At, 0, 1); PG8_STAGE(PG8_SA(0, 0), a2, voffA);
            PG8_BAR; PG8_WAIT_L(0); PG8_MMA(1, 0, At, B0); PG8_BAR; PG8_SCHED;
            PG8_STAGE(PG8_SB(0, 1), b2 + hstep, voffB);
            PG8_WAIT_V(6); PG8_BAR; PG8_MMA(1, 1, At, B1); PG8_BAR;
            PG8_LDB(B0, 1, 0); PG8_SCHED; PG8_LDA(At, 1, 0); PG8_STAGE(PG8_SA(0, 1), a2 + hstep, voffA);
            PG8_WAIT_L(8); PG8_BAR; PG8_WAIT_L(0); PG8_MMA(0, 0, At, B0); PG8_BAR; PG8_SCHED;
            PG8_LDB(B1, 1, 1); PG8_STAGE(PG8_SB(1, 0), b3, voffB);
            PG8_BAR; PG8_WAIT_L(0); PG8_MMA(0, 1, At, B1); PG8_BAR;
            PG8_LDA(At, 1, 1); PG8_STAGE(PG8_SA(1, 0), a3, voffA);
            PG8_BAR; PG8_WAIT_L(0); PG8_MMA(1, 0, At, B0); PG8_BAR; PG8_SCHED;
            PG8_STAGE(PG8_SB(1, 1), b3 + hstep, voffB);
            PG8_WAIT_V(6); PG8_BAR; PG8_MMA(1, 1, At, B1); PG8_BAR;
            }
        }
        if constexpr (ALIGN_EPI) { if (wr == 0) PG8_BAR; }
        if constexpr (!Epi::AFTER_DRAIN) { E(acc, cur, wr, wc, fr, fq); S.done(cur); }
        if (!has_next) break;
#pragma unroll
        for (int a = 0; a < 2; ++a)
#pragma unroll
            for (int b = 0; b < 2; ++b)
#pragma unroll
                for (int m = 0; m < 4; ++m)
#pragma unroll
                    for (int n = 0; n < 2; ++n) acc[a][b][m][n] = (f32x4){0.f, 0.f, 0.f, 0.f};
        cur = nxt; cA = nA; cB = nB; ++ui;
        if constexpr (ALIGN_EPI) { if (wr == 1) PG8_BAR; }
    }
    PG8_WAIT_V(0);
    if constexpr (!ALIGN_EPI) { if (wr == 0) PG8_BAR; }
    PG8_BAR;
    if constexpr (Epi::AFTER_DRAIN) { E.fused(acc, cur, wr, wc, fr, fq, lds, wid, lane); S.done(cur); }
#undef PG8_SA
#undef PG8_SB
#undef PG8_STAGE
#undef PG8_LDA
#undef PG8_LDB
#undef PG8_MMA
#undef PG8_WAIT_V
#undef PG8_WAIT_L
#undef PG8_BAR
#undef PG8_SCHED
}
}

struct EpiInP {
    static constexpr bool PERM = true, AFTER_DRAIN = false;
    unsigned char* ws; const float* b_gate;
    __device__ __forceinline__ void operator()(const f32x4 (&acc)[2][2][4][2], const pg8::Unit& u, int wr, int wc, int fr, int fq) const {
        const int pn = u.pn, cw = wc * 32 + 8 * fq, rowb = u.pm * 256 + wr * 64 + fr;
        if (pn < 4) {
            const int i0 = (cw & 63) >> 1;
            bf16_t* base = (bf16_t*)(ws + (pn < 2 ? WS_DQ : WS_DK)) + (pn & 1) * 256 + cw;
            const float sc = pn < 2 ? QSCALE : 1.0f;
            const float* COS = (const float*)(ws + WS_COS) + i0; const float* SIN = (const float*)(ws + WS_SIN) + i0;
#pragma unroll
            for (int ai = 0; ai < 2; ++ai)
#pragma unroll
                for (int m = 0; m < 4; ++m) { const int row = rowb + ai * 128 + m * 16;
                    const f32x4 c = *(const f32x4*)(COS + (size_t)row * 32), s = *(const f32x4*)(SIN + (size_t)row * 32);
#pragma unroll
                    for (int bj = 0; bj < 2; ++bj) { const f32x4 v0 = acc[ai][bj][m][0], v1 = acc[ai][bj][m][1]; u32x4 w;
                        w.x = cvtpk((v0[0] * c[0] - v0[1] * s[0]) * sc, (v0[1] * c[0] + v0[0] * s[0]) * sc);
                        w.y = cvtpk((v0[2] * c[1] - v0[3] * s[1]) * sc, (v0[3] * c[1] + v0[2] * s[1]) * sc);
                        w.z = cvtpk((v1[0] * c[2] - v1[1] * s[2]) * sc, (v1[1] * c[2] + v1[0] * s[2]) * sc);
                        w.w = cvtpk((v1[2] * c[3] - v1[3] * s[3]) * sc, (v1[3] * c[3] + v1[2] * s[3]) * sc);
                        *(u32x4*)(base + (size_t)row * 512 + bj * 128) = w; } }
        } else if (pn < 12) {
            bf16_t* base; int pitch; float mul = 1.0f; bool act = false;
            if (pn < 6) { base = (bf16_t*)(ws + WS_DV) + (pn - 4) * 256; pitch = 512; }
            else if (pn == 6) { base = (bf16_t*)(ws + WS_GQ); pitch = 256; mul = 0.125f; }
            else if (pn == 7) { base = (bf16_t*)(ws + WS_GK); pitch = 256; }
            else if (pn < 10) { base = (bf16_t*)(ws + WS_GV) + (pn - 8) * 256; pitch = 512; }
            else { base = (bf16_t*)(ws + WS_GR) + (pn - 10) * 256; pitch = 512; act = true; }
            base += cw;
#pragma unroll
            for (int ai = 0; ai < 2; ++ai)
#pragma unroll
                for (int m = 0; m < 4; ++m) { const int row = rowb + ai * 128 + m * 16;
#pragma unroll
                    for (int bj = 0; bj < 2; ++bj) { f32x4 v0 = acc[ai][bj][m][0] * mul, v1 = acc[ai][bj][m][1] * mul;
                        if (act) { v0 = (f32x4){silu_f(v0[0]), silu_f(v0[1]), silu_f(v0[2]), silu_f(v0[3])}; v1 = (f32x4){silu_f(v1[0]), silu_f(v1[1]), silu_f(v1[2]), silu_f(v1[3])}; }
                        u32x4 w; w.x = cvtpk(v0[0], v0[1]); w.y = cvtpk(v0[2], v0[3]); w.z = cvtpk(v1[0], v1[1]); w.w = cvtpk(v1[2], v1[3]);
                        *(u32x4*)(base + (size_t)row * pitch + bj * 128) = w; } }
        } else {
            float* base = (float*)(ws + WS_GLOG) + cw;
#pragma unroll
            for (int bj = 0; bj < 2; ++bj) { const f32x4 b0 = *(const f32x4*)(b_gate + bj * 128 + cw), b1 = *(const f32x4*)(b_gate + bj * 128 + cw + 4);
#pragma unroll
                for (int ai = 0; ai < 2; ++ai)
#pragma unroll
                    for (int m = 0; m < 4; ++m) { const int row = rowb + ai * 128 + m * 16; const f32x4 z0 = acc[ai][bj][m][0] + b0, z1 = acc[ai][bj][m][1] + b1; f32x4 o0, o1;
#pragma unroll
                        for (int q = 0; q < 4; ++q) { o0[q] = (fminf(z0[q], 0.f) - __logf(1.0f + __expf(-fabsf(z0[q])))) * (1.0f / 16.0f); o1[q] = (fminf(z1[q], 0.f) - __logf(1.0f + __expf(-fabsf(z1[q])))) * (1.0f / 16.0f); }
                        float* d = base + (size_t)row * 256 + bj * 128; *(f32x4*)d = o0; *(f32x4*)(d + 4) = o1; } }
        }
    }
};
struct EpiOutP {
    static constexpr bool PERM = false, AFTER_DRAIN = false;
    const Params* p;
    __device__ __forceinline__ void operator()(const f32x4 (&acc)[2][2][4][2], const pg8::Unit& u, int wr, int wc, int fr, int fq) const {
        const float* ada = (const float*)(p->ws + WS_ADA); const float* stats = (const float*)(p->ws + WS_STATS);
        const int rowb = u.pm * 256 + wr * 64 + fr, col0 = u.pn * 256 + wc * 32 + 4 * fq, b = (u.pm * 256) / SEQ;
        float mean[2][4], rstd[2][4];
#pragma unroll
        for (int ai = 0; ai < 2; ++ai)
#pragma unroll
            for (int m = 0; m < 4; ++m) { const int row = rowb + ai * 128 + m * 16; mean[ai][m] = stats[2 * row]; rstd[ai][m] = stats[2 * row + 1]; }
#pragma unroll
        for (int bj = 0; bj < 2; ++bj)
#pragma unroll
            for (int n = 0; n < 2; ++n) { const int col = col0 + bj * 128 + n * 16;
                const f32x4 g = *(const f32x4*)(p->ln_in_g + col), bb = *(const f32x4*)(p->ln_in_b + col), gt = 1.0f + *(const f32x4*)(ada + b * 6144 + 2048 + col);
#pragma unroll
                for (int ai = 0; ai < 2; ++ai)
#pragma unroll
                    for (int m = 0; m < 4; ++m) { const size_t off = (size_t)(rowb + ai * 128 + m * 16) * D + col;
                        const f32x4 xv = *(const f32x4*)(p->x + off); const f32x4 h0 = (xv - mean[ai][m]) * rstd[ai][m] * g + bb;
                        *(f32x4*)(p->out + off) = h0 * DN_ALPHA + gt * acc[ai][bj][m][n]; } }
    }
};
struct EpiUpRawP {
    static constexpr bool PERM = true, AFTER_DRAIN = false;
    bf16_t* UP;
    __device__ __forceinline__ void operator()(const f32x4 (&acc)[2][2][4][2], const pg8::Unit& u, int wr, int wc, int fr, int fq) const {
        const int rowb = u.pm * 256 + wr * 64 + fr; bf16_t* base = UP + u.pn * 256 + wc * 32 + 8 * fq;
#pragma unroll
        for (int ai = 0; ai < 2; ++ai)
#pragma unroll
            for (int m = 0; m < 4; ++m)
#pragma unroll
                for (int bj = 0; bj < 2; ++bj) { const f32x4 v0 = acc[ai][bj][m][0], v1 = acc[ai][bj][m][1];
                    u32x4 w; w.x = cvtpk(v0[0], v0[1]); w.y = cvtpk(v0[2], v0[3]); w.z = cvtpk(v1[0], v1[1]); w.w = cvtpk(v1[2], v1[3]);
                    *(u32x4*)(base + (size_t)(rowb + ai * 128 + m * 16) * F2 + bj * 128) = w; }
    }
};
struct EpiDownP {
    static constexpr bool PERM = false, AFTER_DRAIN = false;
    const Params* p; int row_off;
    __device__ __forceinline__ void operator()(const f32x4 (&acc)[2][2][4][2], const pg8::Unit& u, int wr, int wc, int fr, int fq) const {
        const float* ada = (const float*)(p->ws + WS_ADA);
        const int rowb = row_off + u.pm * 256 + wr * 64 + fr, col0 = u.pn * 256 + wc * 32 + 4 * fq, b = (row_off + u.pm * 256) / SEQ;
#pragma unroll
        for (int bj = 0; bj < 2; ++bj)
#pragma unroll
            for (int n = 0; n < 2; ++n) { const int col = col0 + bj * 128 + n * 16; const f32x4 gt = 1.0f + *(const f32x4*)(ada + b * 6144 + 5120 + col);
#pragma unroll
                for (int ai = 0; ai < 2; ++ai)
#pragma unroll
                    for (int m = 0; m < 4; ++m) { f32x4* o = (f32x4*)(p->out + (size_t)(rowb + ai * 128 + m * 16) * D + col); *o = (*o) * DN_ALPHA + gt * acc[ai][bj][m][n]; } }
    }
};
template <class Epi> __device__ __forceinline__ void gemm_pg8(unsigned char* lds, const bf16_t* A, const bf16_t* Bt, int Mrows, int N, int K, const Epi& e) {
    pg8::Gemm g{A, Bt, Mrows, N, K}; pg8::StaticOrder S; S.init(Mrows, N, (int)gridDim.x, (int)blockIdx.x);
    pg8::gemm_phase<Epi, pg8::StaticOrder, true, true>((PG8_LAS unsigned char*)lds, g, S, e);
}

__device__ void phase_attn_naive(const Params& p, float* DIFF, int bid, int nb) {
    const bf16_t* DQ = (const bf16_t*)(p.ws + WS_DQ); const bf16_t* DK = (const bf16_t*)(p.ws + WS_DK); const bf16_t* DV = (const bf16_t*)(p.ws + WS_DV);
    const float lam = lambda_full(p);
    const int total = BATCH * NH * SEQ * 4;
    for (int w = bid * blockDim.x + threadIdx.x; w < total; w += nb * blockDim.x) {
        const int sl = w & 3, bh = (w >> 2) & 15, i = SEQ - 1 - (w >> 6), b = bh >> 2, h = bh & 3;
        const size_t rowq = (size_t)b * SEQ + i;
        float o0[32];
#pragma unroll
        for (int mp = 0; mp < 2; ++mp) {
            float q[64];
            { const u32x4* qp = (const u32x4*)(DQ + rowq * 512 + h * 128 + mp * 64);
#pragma unroll
              for (int c8 = 0; c8 < 8; ++c8) { const u32x4 u = qp[c8];
                  q[8 * c8 + 0] = bflo(u.x); q[8 * c8 + 1] = bfhi(u.x); q[8 * c8 + 2] = bflo(u.y); q[8 * c8 + 3] = bfhi(u.y);
                  q[8 * c8 + 4] = bflo(u.z); q[8 * c8 + 5] = bfhi(u.z); q[8 * c8 + 6] = bflo(u.w); q[8 * c8 + 7] = bfhi(u.w); } }
            float o[32];
#pragma unroll
            for (int e = 0; e < 32; ++e) o[e] = 0.f;
            float mx = -INFINITY, l = 0.f;
            for (int j = 0; j <= i; ++j) {
                const size_t rowk = (size_t)b * SEQ + j;
                const u32x4* kp = (const u32x4*)(DK + rowk * 512 + h * 128 + mp * 64);
                float s0 = 0.f, s1 = 0.f;
#pragma unroll
                for (int c8 = 0; c8 < 8; ++c8) { const u32x4 u = kp[c8];
                    s0 += q[8 * c8 + 0] * bflo(u.x); s1 += q[8 * c8 + 1] * bfhi(u.x); s0 += q[8 * c8 + 2] * bflo(u.y); s1 += q[8 * c8 + 3] * bfhi(u.y);
                    s0 += q[8 * c8 + 4] * bflo(u.z); s1 += q[8 * c8 + 5] * bfhi(u.z); s0 += q[8 * c8 + 6] * bflo(u.w); s1 += q[8 * c8 + 7] * bfhi(u.w); }
                const float s = s0 + s1;
                float pr;
                if (s > mx) { const float f = exp2f(mx - s); l = l * f + 1.f;
#pragma unroll
                    for (int e = 0; e < 32; ++e) o[e] *= f;
                    mx = s; pr = 1.f; }
                else { pr = exp2f(s - mx); l += pr; }
                const u32x4* vp = (const u32x4*)(DV + rowk * 512 + h * 128 + sl * 32);
#pragma unroll
                for (int c8 = 0; c8 < 4; ++c8) { const u32x4 u = vp[c8];
                    o[8 * c8 + 0] += pr * bflo(u.x); o[8 * c8 + 1] += pr * bfhi(u.x); o[8 * c8 + 2] += pr * bflo(u.y); o[8 * c8 + 3] += pr * bfhi(u.y);
                    o[8 * c8 + 4] += pr * bflo(u.z); o[8 * c8 + 5] += pr * bfhi(u.z); o[8 * c8 + 6] += pr * bflo(u.w); o[8 * c8 + 7] += pr * bfhi(u.w); }
            }
            const float il = 1.0f / l;
            if (mp == 0) {
#pragma unroll
                for (int e = 0; e < 32; ++e) o0[e] = o[e] * il;
            } else {
                float* dp = DIFF + rowq * 512 + h * 128 + sl * 32;
#pragma unroll
                for (int e = 0; e < 32; e += 4) *(f32x4*)(dp + e) = (f32x4){o0[e] - lam * o[e] * il, o0[e + 1] - lam * o[e + 1] * il, o0[e + 2] - lam * o[e + 2] * il, o0[e + 3] - lam * o[e + 3] * il};
            }
        }
    }
}

__device__ void phase_gla_naive(const Params& p, float* GO, int bid, int nb) {
    const bf16_t* GQ = (const bf16_t*)(p.ws + WS_GQ); const bf16_t* GK = (const bf16_t*)(p.ws + WS_GK); const bf16_t* GV = (const bf16_t*)(p.ws + WS_GV);
    const float* GLOG = (const float*)(p.ws + WS_GLOG);
    for (int w = bid * blockDim.x + threadIdx.x; w < BATCH * NH * 128; w += nb * blockDim.x) {
        const int dv = w & 127, bh = w >> 7, b = bh >> 2, h = bh & 3;
        float s[64];
#pragma unroll
        for (int d = 0; d < 64; ++d) s[d] = 0.f;
        for (int t = 0; t < SEQ; ++t) {
            const size_t row = (size_t)b * SEQ + t;
            const float v = bf2f(GV[row * 512 + h * 128 + dv]);
            const u32x4* qp = (const u32x4*)(GQ + row * 256 + h * 64); const u32x4* kp = (const u32x4*)(GK + row * 256 + h * 64);
            const f32x4* gp = (const f32x4*)(GLOG + row * 256 + h * 64);
            float o = 0.f;
#pragma unroll
            for (int c8 = 0; c8 < 8; ++c8) {
                const u32x4 qu = qp[c8], ku = kp[c8]; const f32x4 g0 = gp[2 * c8], g1 = gp[2 * c8 + 1];
                const float qf[8] = {bflo(qu.x), bfhi(qu.x), bflo(qu.y), bfhi(qu.y), bflo(qu.z), bfhi(qu.z), bflo(qu.w), bfhi(qu.w)};
                const float kf[8] = {bflo(ku.x), bfhi(ku.x), bflo(ku.y), bfhi(ku.y), bflo(ku.z), bfhi(ku.z), bflo(ku.w), bfhi(ku.w)};
                const float gf[8] = {g0[0], g0[1], g0[2], g0[3], g1[0], g1[1], g1[2], g1[3]};
#pragma unroll
                for (int e = 0; e < 8; ++e) { const int d = 8 * c8 + e; s[d] = __expf(gf[e]) * s[d] + kf[e] * v; o += qf[e] * s[d]; }
            }
            GO[row * 512 + h * 128 + dv] = o;
        }
    }
}

__device__ void phase_mixprep(const Params& p, const float* DIFF, const float* GO, int bid, int nb) {
    bf16_t* MIX = (bf16_t*)(p.ws + WS_MIX); const bf16_t* GR = (const bf16_t*)(p.ws + WS_GR);
    const int lane = threadIdx.x & 63, wpb = blockDim.x >> 6, gw = bid * wpb + (threadIdx.x >> 6), ngw = nb * wpb;
    for (int m = gw; m < M; m += ngw) {
        const bool gla = lane >= 32; const int cb = 16 * (lane & 31);
        if (!gla && !DIFF) continue;
        const float* src = (gla ? GO : DIFF) + (size_t)m * 512 + cb;
        float v[16]; float ss = 0.f;
#pragma unroll
        for (int e = 0; e < 16; e += 4) { const f32x4 t = *(const f32x4*)(src + e); v[e] = t[0]; v[e + 1] = t[1]; v[e + 2] = t[2]; v[e + 3] = t[3]; ss += (t[0] * t[0] + t[1] * t[1]) + (t[2] * t[2] + t[3] * t[3]); }
        ss += __shfl_xor(ss, 1); ss += __shfl_xor(ss, 2); ss += __shfl_xor(ss, 4);
        const float r = 1.0f / sqrtf(ss * (1.f / 128.f) + LN_EPS);
        const float* nw = (gla ? p.gla_norm_w : p.diff_norm_w) + (cb & 127);
        unsigned w[8];
#pragma unroll
        for (int e = 0; e < 16; e += 2) {
            float a = v[e] * r * nw[e], c = v[e + 1] * r * nw[e + 1];
            if (gla) { a *= bf2f(GR[(size_t)m * 512 + cb + e]); c *= bf2f(GR[(size_t)m * 512 + cb + e + 1]); }
            else { a *= (1.0f - LAMBDA_INIT); c *= (1.0f - LAMBDA_INIT); }
            w[e >> 1] = pk2(a, c);
        }
        u32x4* dst = (u32x4*)(MIX + (size_t)m * D + (gla ? 512 : 0) + cb);
        dst[0] = (u32x4){w[0], w[1], w[2], w[3]}; dst[1] = (u32x4){w[4], w[5], w[6], w[7]};
    }
}

__device__ void phase_convact(const Params& p, int half, int bid, int nb) {
    const bf16_t* UP = (const bf16_t*)(p.ws + WS_UPH); bf16_t* ACT = (bf16_t*)(p.ws + WS_ACTH);
    const int total = 8192 * (F / 4);
    for (int e = bid * blockDim.x + threadIdx.x; e < total; e += nb * blockDim.x) {
        const int t = e / (F / 4), j0 = (e % (F / 4)) * 4, s = (t + half * 8192) & (SEQ - 1);
        const int ca = 256 * (j0 >> 7) + (j0 & 127), cbb = ca + 128;
        float a[4], bq[4];
#pragma unroll
        for (int q = 0; q < 4; ++q) { a[q] = p.conv_b[j0 + q]; bq[q] = p.conv_b[F + j0 + q]; }
#pragma unroll
        for (int k = 0; k < 3; ++k) {
            const int dt = 2 - k;
            if (s - dt >= 0) {
                const u32x2 ua = *(const u32x2*)(UP + (size_t)(t - dt) * F2 + ca), ub = *(const u32x2*)(UP + (size_t)(t - dt) * F2 + cbb);
                const float xa[4] = {bflo(ua.x), bfhi(ua.x), bflo(ua.y), bfhi(ua.y)}, xb[4] = {bflo(ub.x), bfhi(ub.x), bflo(ub.y), bfhi(ub.y)};
#pragma unroll
                for (int q = 0; q < 4; ++q) { a[q] += p.conv_w[k * F2 + j0 + q] * xa[q]; bq[q] += p.conv_w[k * F2 + F + j0 + q] * xb[q]; }
            }
        }
        u32x2 w; w.x = pk2(silu_f(a[0]) * bq[0], silu_f(a[1]) * bq[1]); w.y = pk2(silu_f(a[2]) * bq[2], silu_f(a[3]) * bq[3]);
        *(u32x2*)(ACT + (size_t)t * F + j0) = w;
    }
}

namespace attn {
#define ATT_LAS __attribute__((address_space(3)))
typedef float f32x16 __attribute__((ext_vector_type(16)));
typedef short s16x4 __attribute__((ext_vector_type(4)));
typedef short v4i16_t __attribute__((ext_vector_type(4)));
constexpr int KVBUF = 32768, OFF_K0 = 0, OFF_K1 = 8192, OFF_V = 16384, OFF_XCH = 65536, OFF_WSF = 131072;
constexpr float THR = 6.0f, NEG = -1e30f;
__device__ __forceinline__ int crow(int r, int hi) { return (r & 3) + 8 * (r >> 2) + 4 * hi; }
__device__ __forceinline__ void glds16(const void* g, ATT_LAS unsigned char* dst) { __builtin_amdgcn_global_load_lds((const unsigned*)g, (ATT_LAS unsigned*)dst, 16, 0, 0); }
__device__ __forceinline__ s16x4 vtr(const ATT_LAS unsigned char* p) { return __builtin_bit_cast(s16x4, __builtin_amdgcn_ds_read_tr16_b64_v4i16((ATT_LAS v4i16_t*)p)); }
__device__ __forceinline__ float swap_max(float m) { auto rr = __builtin_amdgcn_permlane32_swap(__float_as_uint(m), __float_as_uint(m), false, false); return fmaxf(__uint_as_float(rr[0]), __uint_as_float(rr[1])); }
__device__ __forceinline__ float swap_sum(float m) { auto rr = __builtin_amdgcn_permlane32_swap(__float_as_uint(m), __float_as_uint(m), false, false); return __uint_as_float(rr[0]) + __uint_as_float(rr[1]); }

__device__ __forceinline__ void stage_tile(ATT_LAS unsigned char* buf, const bf16_t* Kg, const bf16_t* Vg, int t, int wid, int lane) {
    const size_t ro = (size_t)t * 64 * 512;
    glds16(Kg + ro + (size_t)lane * 512 + wid * 8, buf + OFF_K0 + wid * 1024);
    glds16(Kg + ro + (size_t)lane * 512 + 64 + wid * 8, buf + OFF_K1 + wid * 1024);
#pragma unroll
    for (int i = 0; i < 2; ++i) { const int pp = wid + 8 * i;
        glds16(Vg + ro + (size_t)(16 * (pp & 3) + (lane >> 2)) * 512 + (pp >> 2) * 32 + (lane & 3) * 8, buf + OFF_V + pp * 1024); }
}

template <bool MASK>
__device__ __forceinline__ void tile_step(const ATT_LAS unsigned char* buf, int mp, int lane, int r32, int hi, const bf16x8 (&qr)[4], f32x16 (&o)[4], float& mref, float& lsum,
                                          ATT_LAS float* wsf, int key0, int qabs) {
    const ATT_LAS unsigned char* kp = buf + (mp ? OFF_K1 : OFF_K0) + hi * 1024 + r32 * 16;
    f32x16 p0 = {}, p1 = {};
#pragma unroll
    for (int d0 = 0; d0 < 4; ++d0) {
        const bf16x8 a0 = *(const ATT_LAS bf16x8*)(kp + d0 * 2048), a1 = *(const ATT_LAS bf16x8*)(kp + d0 * 2048 + 512);
        p0 = __builtin_amdgcn_mfma_f32_32x32x16_bf16(a0, qr[d0], p0, 0, 0, 0);
        p1 = __builtin_amdgcn_mfma_f32_32x32x16_bf16(a1, qr[d0], p1, 0, 0, 0);
    }
    if (MASK) {
#pragma unroll
        for (int r = 0; r < 16; ++r) { const int key = key0 + crow(r, hi); if (key > qabs) p0[r] = NEG; if (key + 32 > qabs) p1[r] = NEG; }
    }
    float m = fmaxf(p0[0], p1[0]);
#pragma unroll
    for (int r = 1; r < 16; ++r) m = fmaxf(m, fmaxf(p0[r], p1[r]));
    const float rm = swap_max(m);
    if (__any(rm > mref + THR)) {
        const float mnew = fmaxf(mref, rm), f = __builtin_amdgcn_exp2f(mref - mnew);
        lsum *= f; mref = mnew;
        if (hi == 0) wsf[r32] = f;
#pragma unroll
        for (int g = 0; g < 4; ++g) { float f4[4];
#pragma unroll
            for (int i = 0; i < 4; ++i) f4[i] = wsf[8 * g + 4 * hi + i];
#pragma unroll
            for (int d0 = 0; d0 < 4; ++d0)
#pragma unroll
                for (int i = 0; i < 4; ++i) o[d0][4 * g + i] *= f4[i]; }
    }
    float s = 0.f;
#pragma unroll
    for (int r = 0; r < 16; ++r) { p0[r] = __builtin_amdgcn_exp2f(p0[r] - mref); p1[r] = __builtin_amdgcn_exp2f(p1[r] - mref); s += p0[r] + p1[r]; }
    lsum += s;
    bf16x8 pa[4];
    { u32x4 w;
      w.x = cvtpk(p0[0], p0[1]); w.y = cvtpk(p0[2], p0[3]); w.z = cvtpk(p0[4], p0[5]); w.w = cvtpk(p0[6], p0[7]); pa[0] = __builtin_bit_cast(bf16x8, w);
      w.x = cvtpk(p0[8], p0[9]); w.y = cvtpk(p0[10], p0[11]); w.z = cvtpk(p0[12], p0[13]); w.w = cvtpk(p0[14], p0[15]); pa[1] = __builtin_bit_cast(bf16x8, w);
      w.x = cvtpk(p1[0], p1[1]); w.y = cvtpk(p1[2], p1[3]); w.z = cvtpk(p1[4], p1[5]); w.w = cvtpk(p1[6], p1[7]); pa[2] = __builtin_bit_cast(bf16x8, w);
      w.x = cvtpk(p1[8], p1[9]); w.y = cvtpk(p1[10], p1[11]); w.z = cvtpk(p1[12], p1[13]); w.w = cvtpk(p1[14], p1[15]); pa[3] = __builtin_bit_cast(bf16x8, w); }
    const ATT_LAS unsigned char* vp = buf + OFF_V + ((lane >> 4) & 1) * 32 + (lane & 3) * 8 + (4 * hi + ((lane & 15) >> 2)) * 64;
#pragma unroll
    for (int d0 = 0; d0 < 4; ++d0) {
#pragma unroll
        for (int ks = 0; ks < 4; ++ks) {
            const s16x4 lo = vtr(vp + d0 * 4096 + ks * 1024), hh = vtr(vp + d0 * 4096 + ks * 1024 + 512);
            const bf16x8 vb = (bf16x8){lo[0], lo[1], lo[2], lo[3], hh[0], hh[1], hh[2], hh[3]};
            o[d0] = __builtin_amdgcn_mfma_f32_32x32x16_bf16(pa[ks], vb, o[d0], 0, 0, 0);
        }
    }
}

__device__ __forceinline__ void attn_unit(const Params& p, ATT_LAS unsigned char* lds, int b, int h, int qb, float lam) {
    int tid_ = threadIdx.x; asm volatile("" : "+v"(tid_));
    const int tid = tid_, lane = tid & 63, r32 = lane & 31, hi = lane >> 5, wid = __builtin_amdgcn_readfirstlane(tid >> 6), mp = wid >> 2, wq = wid & 3;
    const int q0 = qb * 128, NT = 2 * (qb + 1);
    const size_t rowbase = (size_t)b * SEQ;
    const bf16_t* Kg = (const bf16_t*)(p.ws + WS_DK) + rowbase * 512 + h * 128;
    const bf16_t* Vg = (const bf16_t*)(p.ws + WS_DV) + rowbase * 512 + h * 128;
    const bf16_t* Qw = (const bf16_t*)(p.ws + WS_DQ) + (rowbase + q0 + wq * 32 + r32) * 512 + h * 128 + mp * 64;
    ATT_LAS float* wsf = (ATT_LAS float*)(lds + OFF_WSF) + wid * 64;
    stage_tile(lds, Kg, Vg, 0, wid, lane);
    bf16x8 qr[4];
#pragma unroll
    for (int d0 = 0; d0 < 4; ++d0) qr[d0] = *(const bf16x8*)(Qw + d0 * 16 + hi * 8);
    f32x16 o[4];
#pragma unroll
    for (int d0 = 0; d0 < 4; ++d0) o[d0] = f32x16{};
    float mref = NEG, lsum = 0.f;
    const int qabs = q0 + wq * 32 + r32;
    for (int t = 0; t < NT; ++t) {
        asm volatile("s_waitcnt vmcnt(0)" ::: "memory");
        __syncthreads();
        if (t + 1 < NT) stage_tile(lds + ((t + 1) & 1) * KVBUF, Kg, Vg, t + 1, wid, lane);
        const ATT_LAS unsigned char* buf = lds + (t & 1) * KVBUF;
        if (t < NT - 2) tile_step<false>(buf, mp, lane, r32, hi, qr, o, mref, lsum, wsf, t * 64, qabs);
        else if (!(t == NT - 1 && wq < 2)) tile_step<true>(buf, mp, lane, r32, hi, qr, o, mref, lsum, wsf, t * 64, qabs);
    }
    const float linv = 1.0f / swap_sum(lsum);
    if (hi == 0) wsf[r32] = linv;
#pragma unroll
    for (int g = 0; g < 4; ++g) { float f4[4];
#pragma unroll
        for (int i = 0; i < 4; ++i) f4[i] = wsf[8 * g + 4 * hi + i];
#pragma unroll
        for (int d0 = 0; d0 < 4; ++d0)
#pragma unroll
            for (int i = 0; i < 4; ++i) o[d0][4 * g + i] *= f4[i]; }
    ATT_LAS float* xch = (ATT_LAS float*)(lds + OFF_XCH) + (size_t)wq * 4 * 16 * 64 + lane;
    if (mp == 1) {
#pragma unroll
        for (int d0 = 0; d0 < 4; ++d0)
#pragma unroll
            for (int r = 0; r < 16; ++r) xch[(d0 * 16 + r) * 64] = o[d0][r];
    }
    __syncthreads();
    if (mp == 0) {
        float nw[4];
#pragma unroll
        for (int d0 = 0; d0 < 4; ++d0) nw[d0] = p.diff_norm_w[32 * d0 + r32] * (1.0f - LAMBDA_INIT);
        bf16_t* Ow = (bf16_t*)(p.ws + WS_MIX) + (rowbase + q0 + wq * 32) * D + h * 128 + r32;
#pragma unroll
        for (int r = 0; r < 16; ++r) {
            float dsq = 0.f; float dv[4];
#pragma unroll
            for (int d0 = 0; d0 < 4; ++d0) { dv[d0] = o[d0][r] - lam * xch[(d0 * 16 + r) * 64]; dsq += dv[d0] * dv[d0]; }
            dsq += __shfl_xor(dsq, 1); dsq += __shfl_xor(dsq, 2); dsq += __shfl_xor(dsq, 4); dsq += __shfl_xor(dsq, 8); dsq += __shfl_xor(dsq, 16);
            const float rs = 1.0f / sqrtf(dsq * (1.0f / 128.0f) + LN_EPS);
            bf16_t* orow = Ow + (size_t)crow(r, hi) * D;
#pragma unroll
            for (int d0 = 0; d0 < 4; ++d0) orow[32 * d0] = (bf16_t)f2bf(dv[d0] * rs * nw[d0]);
        }
    }
    __syncthreads();
}

__device__ void phase_attn(const Params& p, unsigned char* lds_generic) {
    ATT_LAS unsigned char* lds = (ATT_LAS unsigned char*)lds_generic;
    const float lam = lambda_full(p);
    const int G = gridDim.x, bx = blockIdx.x, vcu = (G % 8 == 0) ? (bx % 8) * (G / 8) + bx / 8 : bx;
    for (int item = vcu; item < 256; item += G) {
        const int bh = item >> 4, s = item & 15;
        attn_unit(p, lds, bh >> 2, bh & 3, 31 - s, lam);
        attn_unit(p, lds, bh >> 2, bh & 3, s, lam);
    }
}
}

namespace gla {
#define GL_LAS __attribute__((address_space(3)))
typedef float f32x16 __attribute__((ext_vector_type(16)));
typedef short s16x4 __attribute__((ext_vector_type(4)));
typedef short v4i16_t __attribute__((ext_vector_type(4)));
constexpr size_t WS_DEC = WS_BIG + 176 * MiB;
__device__ __forceinline__ s16x4 vtr(const GL_LAS unsigned char* p) { return __builtin_bit_cast(s16x4, __builtin_amdgcn_ds_read_tr16_b64_v4i16((GL_LAS v4i16_t*)p)); }
__device__ __forceinline__ bf16x8 cat8(s16x4 lo, s16x4 hh) { return (bf16x8){lo[0], lo[1], lo[2], lo[3], hh[0], hh[1], hh[2], hh[3]}; }
__device__ __forceinline__ int crow(int r, int hi) { return (r & 3) + 8 * (r >> 2) + 4 * hi; }

__device__ __forceinline__ void stage_v(GL_LAS unsigned char* VI, const bf16_t* GVh  , int tid) {
    const int tok = tid >> 3, c8 = tid & 7;
    const u32x4* src = (const u32x4*)(GVh + (size_t)tok * 512 + c8 * 16);
    const u32x4 a = src[0], b = src[1];
    GL_LAS unsigned char* dst = VI + (c8 >> 1) * 4096 + tok * 64 + (c8 & 1) * 32;
    *(GL_LAS u32x4*)dst = a; *(GL_LAS u32x4*)(dst + 16) = b;
}

__device__ __forceinline__ void g1_unit(const Params& p, GL_LAS unsigned char* lds, int bh, int c) {
    int tid_ = threadIdx.x; asm volatile("" : "+v"(tid_));
    const int tid = tid_, lane = tid & 63, wid = __builtin_amdgcn_readfirstlane(tid >> 6), hi = lane >> 5, r32 = lane & 31;
    const int b = bh >> 2, h = bh & 3; const size_t row0 = (size_t)b * SEQ + c * 64;
    float* GLOG = (float*)(p.ws + WS_GLOG) + row0 * 256 + h * 64;
    const bf16_t* GK = (const bf16_t*)(p.ws + WS_GK) + row0 * 256 + h * 64;
    const bf16_t* GV = (const bf16_t*)(p.ws + WS_GV) + row0 * 512 + h * 128;
    float* DEC = (float*)(p.ws + WS_DEC) + (size_t)(bh * 64 + c) * 64;
    GL_LAS float* SEG = (GL_LAS float*)lds; GL_LAS unsigned char* KH = lds + 4096; GL_LAS unsigned char* VI = lds + 16384;
    const int d = tid & 63, seg = tid >> 6;
    float g[8], kv[8];
#pragma unroll
    for (int i = 0; i < 8; ++i) { g[i] = GLOG[(size_t)(seg * 8 + i) * 256 + d]; kv[i] = bf2f(GK[(size_t)(seg * 8 + i) * 256 + d]); }
    stage_v(VI, GV, tid);
#pragma unroll
    for (int i = 1; i < 8; ++i) g[i] += g[i - 1];
    SEG[seg * 64 + d] = g[7];
    __syncthreads();
    float pre = 0.f, tot = 0.f;
#pragma unroll
    for (int s = 0; s < 8; ++s) { const float v = SEG[s * 64 + d]; pre += (s < seg) ? v : 0.f; tot += v; }
#pragma unroll
    for (int i = 0; i < 8; ++i) { g[i] += pre; GLOG[(size_t)(seg * 8 + i) * 256 + d] = g[i];
        *(GL_LAS bf16_t*)(KH + (d >> 5) * 4096 + (seg * 8 + i) * 64 + (d & 31) * 2) = (bf16_t)f2bf(kv[i] * __expf(tot - g[i])); }
    if (seg == 0) DEC[d] = __expf(tot);
    __syncthreads();
    const int dblk = wid >> 2, dvb = wid & 3;
    const int toff = ((lane & 15) >> 2) * 64 + ((lane >> 4) & 1) * 32 + (lane & 3) * 8 + hi * 512;
    const GL_LAS unsigned char* ap = KH + dblk * 4096 + toff; const GL_LAS unsigned char* bp = VI + dvb * 4096 + toff;
    f32x16 acc = {};
#pragma unroll
    for (int ks = 0; ks < 4; ++ks) {
        const bf16x8 a = cat8(vtr(ap + ks * 1024), vtr(ap + ks * 1024 + 256)), bb = cat8(vtr(bp + ks * 1024), vtr(bp + ks * 1024 + 256));
        acc = __builtin_amdgcn_mfma_f32_32x32x16_bf16(a, bb, acc, 0, 0, 0);
    }
    float* U = (float*)(p.ws + WS_GLU) + (size_t)(bh * 64 + c) * 8192 + dvb * 32 + r32;
#pragma unroll
    for (int r = 0; r < 16; ++r) U[(size_t)(dblk * 32 + crow(r, hi)) * 128] = acc[r];
    __syncthreads();
}
__device__ void phase_g1(const Params& p, unsigned char* lds_generic) {
    GL_LAS unsigned char* lds = (GL_LAS unsigned char*)lds_generic;
    const int G = gridDim.x, bx = blockIdx.x, vcu = (G % 8 == 0) ? (bx % 8) * (G / 8) + bx / 8 : bx;
    for (int u = vcu; u < 1024; u += G) g1_unit(p, lds, u >> 6, u & 63);
}
__device__ void phase_g2(const Params& p, int bid, int nb) {
    float* GLU = (float*)(p.ws + WS_GLU); const float* DEC = (const float*)(p.ws + WS_DEC);
    for (int e = bid * blockDim.x + threadIdx.x; e < 16 * 8192; e += nb * blockDim.x) {
        const int bh = e >> 13, el = e & 8191, d = el >> 7;
        float* base = GLU + (size_t)bh * 64 * 8192 + el; const float* dec = DEC + (size_t)bh * 64 * 64 + d;
        float s = 0.f;
        for (int c0 = 0; c0 < 64; c0 += 16) {
            float u[16], dc[16];
#pragma unroll
            for (int i = 0; i < 16; ++i) { u[i] = base[(size_t)(c0 + i) * 8192]; dc[i] = dec[(c0 + i) * 64]; }
#pragma unroll
            for (int i = 0; i < 16; ++i) { base[(size_t)(c0 + i) * 8192] = s; s = dc[i] * s + u[i]; }
        }
    }
}
__device__ __forceinline__ void g3_unit(const Params& p, GL_LAS unsigned char* lds, int bh, int c) {
    int tid_ = threadIdx.x; asm volatile("" : "+v"(tid_));
    const int tid = tid_, lane = tid & 63, wid = __builtin_amdgcn_readfirstlane(tid >> 6), hi = lane >> 5, r32 = lane & 31;
    const int b = bh >> 2, h = bh & 3; const size_t row0 = (size_t)b * SEQ + c * 64;
    const float* GB = (const float*)(p.ws + WS_GLOG) + row0 * 256 + h * 64;
    const bf16_t* GQ = (const bf16_t*)(p.ws + WS_GQ) + row0 * 256 + h * 64; const bf16_t* GK = (const bf16_t*)(p.ws + WS_GK) + row0 * 256 + h * 64;
    const bf16_t* GV = (const bf16_t*)(p.ws + WS_GV) + row0 * 512 + h * 128; const bf16_t* GR = (const bf16_t*)(p.ws + WS_GR) + row0 * 512 + h * 128;
    const float* S = (const float*)(p.ws + WS_GLU) + (size_t)(bh * 64 + c) * 8192;
    GL_LAS unsigned char* QI = lds; GL_LAS unsigned char* KI = lds + 8192; GL_LAS unsigned char* VI = lds + 16384; GL_LAS unsigned char* SI = lds + 32768;
    GL_LAS float* OX = (GL_LAS float*)(lds + 49152);
    const int tok = tid >> 3, c8 = tid & 7;
    {
        const f32x4 b0 = *(const f32x4*)(GB + (size_t)tok * 256 + c8 * 8), b1 = *(const f32x4*)(GB + (size_t)tok * 256 + c8 * 8 + 4);
        const u32x4 qu = *(const u32x4*)(GQ + (size_t)tok * 256 + c8 * 8), ku = *(const u32x4*)(GK + (size_t)tok * 256 + c8 * 8);
        const float bv[8] = {b0[0], b0[1], b0[2], b0[3], b1[0], b1[1], b1[2], b1[3]};
        const float qf[8] = {bflo(qu.x), bfhi(qu.x), bflo(qu.y), bfhi(qu.y), bflo(qu.z), bfhi(qu.z), bflo(qu.w), bfhi(qu.w)};
        const float kf[8] = {bflo(ku.x), bfhi(ku.x), bflo(ku.y), bfhi(ku.y), bflo(ku.z), bfhi(ku.z), bflo(ku.w), bfhi(ku.w)};
        float qt[8], kt[8];
#pragma unroll
        for (int j = 0; j < 8; ++j) { qt[j] = qf[j] * __expf(bv[j]); kt[j] = kf[j] * __expf(-bv[j]); }
        *(GL_LAS u32x4*)(QI + c8 * 1024 + tok * 16) = (u32x4){cvtpk(qt[0], qt[1]), cvtpk(qt[2], qt[3]), cvtpk(qt[4], qt[5]), cvtpk(qt[6], qt[7])};
        *(GL_LAS u32x4*)(KI + c8 * 1024 + tok * 16) = (u32x4){cvtpk(kt[0], kt[1]), cvtpk(kt[2], kt[3]), cvtpk(kt[4], kt[5]), cvtpk(kt[6], kt[7])};
    }
    stage_v(VI, GV, tid);
    {
        const f32x4* sp = (const f32x4*)(S + (size_t)tok * 128 + c8 * 16);
        const f32x4 s0 = sp[0], s1 = sp[1], s2 = sp[2], s3 = sp[3];
        GL_LAS unsigned char* dst = SI + (c8 >> 1) * 4096 + tok * 64 + (c8 & 1) * 32;
        *(GL_LAS u32x4*)dst = (u32x4){cvtpk(s0[0], s0[1]), cvtpk(s0[2], s0[3]), cvtpk(s1[0], s1[1]), cvtpk(s1[2], s1[3])};
        *(GL_LAS u32x4*)(dst + 16) = (u32x4){cvtpk(s2[0], s2[1]), cvtpk(s2[2], s2[3]), cvtpk(s3[0], s3[1]), cvtpk(s3[2], s3[3])};
    }
    __syncthreads();
    const int ib = wid >> 2, dvb = wid & 3;
    bf16x8 qfr[4];
#pragma unroll
    for (int d0 = 0; d0 < 4; ++d0) qfr[d0] = *(const GL_LAS bf16x8*)(QI + (2 * d0 + hi) * 1024 + (32 * ib + r32) * 16);
    f32x16 o = {};
    const int tq = ((lane & 15) >> 2) * 64 + ((lane >> 4) & 1) * 32 + (lane & 3) * 8;
    const GL_LAS unsigned char* vp = VI + dvb * 4096 + tq + hi * 256;
    const GL_LAS unsigned char* sp2 = SI + dvb * 4096 + tq + hi * 512;
#pragma unroll
    for (int jb = 0; jb < 2; ++jb) {
        if (jb <= ib) {
            f32x16 pj = {};
#pragma unroll
            for (int d0 = 0; d0 < 4; ++d0) { const bf16x8 kf = *(const GL_LAS bf16x8*)(KI + (2 * d0 + hi) * 1024 + (32 * jb + r32) * 16);
                pj = __builtin_amdgcn_mfma_f32_32x32x16_bf16(kf, qfr[d0], pj, 0, 0, 0); }
            if (jb == ib) {
#pragma unroll
                for (int r = 0; r < 16; ++r) if (crow(r, hi) > r32) pj[r] = 0.f;
            }
            const bf16x8 pa0 = __builtin_bit_cast(bf16x8, (u32x4){cvtpk(pj[0], pj[1]), cvtpk(pj[2], pj[3]), cvtpk(pj[4], pj[5]), cvtpk(pj[6], pj[7])});
            const bf16x8 pa1 = __builtin_bit_cast(bf16x8, (u32x4){cvtpk(pj[8], pj[9]), cvtpk(pj[10], pj[11]), cvtpk(pj[12], pj[13]), cvtpk(pj[14], pj[15])});
            o = __builtin_amdgcn_mfma_f32_32x32x16_bf16(pa0, cat8(vtr(vp + (2 * jb) * 1024), vtr(vp + (2 * jb) * 1024 + 512)), o, 0, 0, 0);
            o = __builtin_amdgcn_mfma_f32_32x32x16_bf16(pa1, cat8(vtr(vp + (2 * jb + 1) * 1024), vtr(vp + (2 * jb + 1) * 1024 + 512)), o, 0, 0, 0);
        }
    }
#pragma unroll
    for (int d0 = 0; d0 < 4; ++d0) o = __builtin_amdgcn_mfma_f32_32x32x16_bf16(qfr[d0], cat8(vtr(sp2 + d0 * 1024), vtr(sp2 + d0 * 1024 + 256)), o, 0, 0, 0);
#pragma unroll
    for (int r = 0; r < 16; ++r) OX[(32 * ib + crow(r, hi)) * 132 + dvb * 32 + r32] = o[r];
    __syncthreads();
    {
        float v[16]; float ss = 0.f;
#pragma unroll
        for (int e = 0; e < 16; ++e) { v[e] = OX[tok * 132 + c8 * 16 + e]; ss += v[e] * v[e]; }
        ss += __shfl_xor(ss, 1); ss += __shfl_xor(ss, 2); ss += __shfl_xor(ss, 4);
        const float rs = 1.0f / sqrtf(ss * (1.0f / 128.0f) + LN_EPS);
        const u32x4 g0 = *(const u32x4*)(GR + (size_t)tok * 512 + c8 * 16), g1 = *(const u32x4*)(GR + (size_t)tok * 512 + c8 * 16 + 8);
        const float gr[16] = {bflo(g0.x), bfhi(g0.x), bflo(g0.y), bfhi(g0.y), bflo(g0.z), bfhi(g0.z), bflo(g0.w), bfhi(g0.w),
                              bflo(g1.x), bfhi(g1.x), bflo(g1.y), bfhi(g1.y), bflo(g1.z), bfhi(g1.z), bflo(g1.w), bfhi(g1.w)};
        const float* nw = p.gla_norm_w + c8 * 16; unsigned w[8];
#pragma unroll
        for (int e = 0; e < 16; e += 2) w[e >> 1] = cvtpk(v[e] * rs * nw[e] * gr[e], v[e + 1] * rs * nw[e + 1] * gr[e + 1]);
        u32x4* dst = (u32x4*)((bf16_t*)(p.ws + WS_MIX) + (row0 + tok) * D + 512 + h * 128 + c8 * 16);
        dst[0] = (u32x4){w[0], w[1], w[2], w[3]}; dst[1] = (u32x4){w[4], w[5], w[6], w[7]};
    }
    __syncthreads();
}
__device__ void phase_g3(const Params& p, unsigned char* lds_generic) {
    GL_LAS unsigned char* lds = (GL_LAS unsigned char*)lds_generic;
    const int G = gridDim.x, bx = blockIdx.x, vcu = (G % 8 == 0) ? (bx % 8) * (G / 8) + bx / 8 : bx;
    for (int u = vcu; u < 1024; u += G) g3_unit(p, lds, u >> 6, u & 63);
}
}

#define LAS __attribute__((address_space(3)))
#define XB_TMO      128
#define XB_XCNT(j)  (256  + 64 * (j))
#define XB_XSUB(j)  (1280 + 64 * (j))
#define XB_XGEN(j)  (2304 + 64 * (j))
#define XB_TOP      3328
#define XB_TOPGEN   3392
#define XCD_BAR_WORDS 3456
#define XB_SPIN_CAP (1u << 18)

__device__ __forceinline__ unsigned xb_ld(unsigned* p)              { return __hip_atomic_load(p, __ATOMIC_RELAXED, __HIP_MEMORY_SCOPE_AGENT); }
__device__ __forceinline__ unsigned xb_add(unsigned* p, unsigned v) { return __hip_atomic_fetch_add(p, v, __ATOMIC_RELAXED, __HIP_MEMORY_SCOPE_AGENT); }
__device__ __forceinline__ unsigned xb_xcc_id() { return (unsigned)__builtin_amdgcn_s_getreg((3 << 11) | 20) & 0xFu; }
#define XB_SPIN(cond, bar) do { unsigned _sp = 0; while (cond) { __builtin_amdgcn_s_sleep(1); \
    if ((++_sp & 255u) == 0u) { if (xb_ld(&(bar)[XB_TMO])) break; if (_sp > XB_SPIN_CAP) { atomicAdd(&(bar)[XB_TMO], 1u); break; } } } } while (0)

struct XcdBarrier {
    unsigned* bar; unsigned x;
    volatile LAS unsigned* st;
};

__device__ __forceinline__ XcdBarrier xcd_barrier_post(unsigned* bar, volatile LAS unsigned* st) {
    XcdBarrier b; b.bar = bar; b.x = xb_xcc_id(); b.st = st;
    if (threadIdx.x == 0) (void)xb_add(&bar[XB_XCNT(b.x)], 1u);
    return b;
}
__device__ __forceinline__ void xcd_barrier_complete(unsigned* bar, unsigned x, unsigned& nloc, unsigned& nx) {
    const unsigned G = gridDim.x * gridDim.y * gridDim.z;
    unsigned sum, cnt, mine, sp = 0u;
    for (;;) {
        sum = 0u; cnt = 0u; mine = 0u;
#pragma unroll
        for (unsigned j = 0; j < 16; ++j) { const unsigned c = xb_ld(&bar[XB_XCNT(j)]); sum += c; cnt += (c > 0u) ? 1u : 0u; mine = (j == x) ? c : mine; }
        if (sum == G) break;
        __builtin_amdgcn_s_sleep(1);
        if ((++sp & 255u) == 0u) { if (xb_ld(&bar[XB_TMO])) break; if (sp > XB_SPIN_CAP) { atomicAdd(&bar[XB_TMO], 1u); break; } }
    }
    nloc = mine > 0u ? mine : 1u; nx = cnt > 0u ? cnt : 1u;
}

__device__ __forceinline__ void xcd_barrier(const XcdBarrier& b) {
    asm volatile("s_waitcnt vmcnt(0)" ::: "memory");
    __syncthreads();
    if (threadIdx.x == 0) {
        unsigned* bar = b.bar;
        __builtin_amdgcn_s_waitcnt(0);
        unsigned nloc = b.st[0], nx = b.st[1];
        if (nloc == 0u) { xcd_barrier_complete(bar, b.x, nloc, nx); b.st[0] = nloc; b.st[1] = nx; }
        const unsigned old = xb_add(&bar[XB_XSUB(b.x)], 1u);
        const unsigned gen = old / nloc;
        if (old + 1u == (gen + 1u) * nloc) {
            __builtin_amdgcn_fence(__ATOMIC_RELEASE, "agent");
            asm volatile("s_waitcnt vmcnt(0)" ::: "memory");
            const unsigned og = xb_add(&bar[XB_TOP], 1u);
            const unsigned tg = og / nx;
            if (og + 1u == (tg + 1u) * nx) xb_add(&bar[XB_TOPGEN], 1u);
            else XB_SPIN(xb_ld(&bar[XB_TOPGEN]) == tg, bar);
            __builtin_amdgcn_fence(__ATOMIC_ACQUIRE, "agent");
            xb_add(&bar[XB_XGEN(b.x)], 1u);
            asm volatile("s_waitcnt vmcnt(0)" ::: "memory");
        } else {
            XB_SPIN(xb_ld(&bar[XB_XGEN(b.x)]) == gen, bar);
            __builtin_amdgcn_fence(__ATOMIC_ACQUIRE, "agent");
            asm volatile("s_waitcnt vmcnt(0)" ::: "memory");
        }
    }
    __syncthreads();
}

template <int PH> __device__ __forceinline__ void run_phase(const Params& p, float* smem, int bid, int nb) {
    if constexpr (PH == 0) { phase_ada(p, smem, bid, nb); phase_wprep(p, smem, bid, nb); phase_rope(p, bid, nb); }
    else if constexpr (PH == 1) phase_ln_in(p, bid, nb);
    else if constexpr (PH == 2) { EpiInP e{p.ws, p.b_gate}; gemm_pg8((unsigned char*)smem, (const bf16_t*)(p.ws + WS_XN), (const bf16_t*)(p.ws + WS_WIN), M, N_INX, D, e); }
    else if constexpr (PH == 3) gla::phase_g1(p, (unsigned char*)smem);
    else if constexpr (PH == 4) gla::phase_g2(p, bid, nb);
    else if constexpr (PH == 5) { attn::phase_attn(p, (unsigned char*)smem); gla::phase_g3(p, (unsigned char*)smem); }
    else if constexpr (PH == 6) { EpiOutP e{&p}; gemm_pg8((unsigned char*)smem, (const bf16_t*)(p.ws + WS_MIX), (const bf16_t*)(p.ws + WS_WOUT), M, D, D, e); }
    else if constexpr (PH == 7) phase_ln_rows(p, p.out, p.ln_attn_g, p.ln_attn_b, (bf16_t*)(p.ws + WS_XN), 3072, 4096, bid, nb);
    else if constexpr (PH == 8 || PH == 11) { constexpr int half = (PH == 11); EpiUpRawP e{(bf16_t*)(p.ws + WS_UPH)};
        gemm_pg8((unsigned char*)smem, (const bf16_t*)(p.ws + WS_XN) + (size_t)half * 8192 * D, (const bf16_t*)(p.ws + WS_WUP), 8192, F2, D, e); }
    else if constexpr (PH == 9 || PH == 12) phase_convact(p, PH == 12, bid, nb);
    else if constexpr (PH == 10 || PH == 13) { constexpr int half = (PH == 13); EpiDownP e{&p, half * 8192};
        gemm_pg8((unsigned char*)smem, (const bf16_t*)(p.ws + WS_ACTH), (const bf16_t*)(p.ws + WS_WDOWN), 8192, D, F, e); }
    else if constexpr (PH == 14) phase_ln_rows(p, p.out, p.ln_ffn_g, p.ln_ffn_b, nullptr, 0, 0, bid, nb);
}
constexpr int LAST_PHASE = 14;

constexpr int NTHREADS = 512;
constexpr int LDS_BYTES = 147456;

template <int PH> __global__ void __launch_bounds__(NTHREADS, 2) k_phase(Params p) {
    extern __shared__ __attribute__((aligned(16))) unsigned char lds[];
    run_phase<PH>(p, (float*)lds, blockIdx.x, gridDim.x);
}
constexpr int MISC_OFF = 135168;
constexpr int CW_BAR = 4096;
constexpr size_t CTL_ZERO_BYTES = 65536;
template <int PH> struct PhaseLoop { static __device__ __forceinline__ void run(const Params& p, float* smem, const XcdBarrier& bar) {
    run_phase<PH>(p, smem, blockIdx.x, gridDim.x);
    if constexpr (PH < LAST_PHASE) { xcd_barrier(bar); PhaseLoop<PH + 1>::run(p, smem, bar); } } };
__global__ void __launch_bounds__(NTHREADS, 2) k_mega(Params p) {
    extern __shared__ __attribute__((aligned(16))) unsigned char lds[];
    volatile LAS unsigned* misc = (volatile LAS unsigned*)((LAS unsigned char*)lds + MISC_OFF);
    if (threadIdx.x < 32) misc[threadIdx.x] = 0u;
    __syncthreads();
    const XcdBarrier bar = xcd_barrier_post((unsigned*)(p.ws + WS_CTL) + CW_BAR, misc + 8);
    PhaseLoop<0>::run(p, (float*)lds, bar);
}

template <int PH> static void launch_phases(const Params& p, int grid, hipStream_t stream) {
    static bool attr_set = false;
    if (!attr_set) { (void)hipFuncSetAttribute((const void*)k_phase<PH>, hipFuncAttributeMaxDynamicSharedMemorySize, LDS_BYTES); attr_set = true; }
    hipLaunchKernelGGL(k_phase<PH>, dim3(grid), dim3(NTHREADS), LDS_BYTES, stream, p);
    if constexpr (PH < LAST_PHASE) launch_phases<PH + 1>(p, grid, stream);
}

extern "C" void kernel_launch(void* const* d_in, const int* in_sizes, int n_in, void* d_out, int out_size, void* d_ws, size_t ws_size, hipStream_t stream) {
    if (n_in != 25 || in_sizes[0] != M * D || out_size != M * D || ws_size < WS_END) {
        fprintf(stderr, "kernel_launch: unexpected shapes (n_in %d, in0 %d, out %d, ws %zu)\n", n_in, n_in > 0 ? in_sizes[0] : -1, out_size, ws_size); return; }
    Params p{};
    p.x = (const float*)d_in[0]; p.c = (const float*)d_in[1]; p.pos = (const int*)d_in[2]; p.ln_in_g = (const float*)d_in[3]; p.ln_in_b = (const float*)d_in[4];
    p.w_ada = (const float*)d_in[5]; p.b_ada = (const float*)d_in[6]; p.w_in = (const float*)d_in[7];
    p.lq1 = (const float*)d_in[8]; p.lk1 = (const float*)d_in[9]; p.lq2 = (const float*)d_in[10]; p.lk2 = (const float*)d_in[11];
    p.diff_norm_w = (const float*)d_in[12]; p.w_gate_up = (const float*)d_in[13]; p.b_gate = (const float*)d_in[14]; p.gla_norm_w = (const float*)d_in[15];
    p.w_out = (const float*)d_in[16]; p.ln_attn_g = (const float*)d_in[17]; p.ln_attn_b = (const float*)d_in[18];
    p.w_up = (const float*)d_in[19]; p.conv_w = (const float*)d_in[20]; p.conv_b = (const float*)d_in[21]; p.w_down = (const float*)d_in[22];
    p.ln_ffn_g = (const float*)d_in[23]; p.ln_ffn_b = (const float*)d_in[24];
    p.out = (float*)d_out; p.ws = (unsigned char*)d_ws;
#if ONE_LAUNCH
    static int grid_blocks = 0;
    if (!grid_blocks) {
        int dev = 0, cus = 0, per_cu = 0;
        (void)hipGetDevice(&dev); (void)hipDeviceGetAttribute(&cus, hipDeviceAttributeMultiprocessorCount, dev);
        (void)hipFuncSetAttribute((const void*)k_mega, hipFuncAttributeMaxDynamicSharedMemorySize, LDS_BYTES);
        (void)hipOccupancyMaxActiveBlocksPerMultiprocessor(&per_cu, (const void*)k_mega, NTHREADS, LDS_BYTES);
        if (per_cu != 1) fprintf(stderr, "note: occupancy query says %d workgroups per CU (expected 1)\n", per_cu);
        grid_blocks = cus;
    }
    (void)hipMemsetAsync((unsigned char*)d_ws + WS_CTL, 0, CTL_ZERO_BYTES, stream);
    void* args[] = {&p};
    hipError_t e = hipLaunchCooperativeKernel((const void*)k_mega, dim3(grid_blocks), dim3(NTHREADS), args, LDS_BYTES, stream);
    if (e != hipSuccess) fprintf(stderr, "cooperative launch failed: %s (grid %d)\n", hipGetErrorString(e), grid_blocks);
#else
    launch_phases<0>(p, 256, stream);
#endif
}
```

```cpp
#include <hip/hip_runtime.h>
#include <stdint.h>
#include <stdio.h>

#ifndef ONE_LAUNCH
#define ONE_LAUNCH 1
#endif

typedef unsigned short bf16_t;
typedef short bf16x8 __attribute__((ext_vector_type(8)));
typedef float f32x4 __attribute__((ext_vector_type(4)));
typedef unsigned u32x4 __attribute__((ext_vector_type(4)));
typedef unsigned u32x2 __attribute__((ext_vector_type(2)));

constexpr int D = 1024, BATCH = 4, SEQ = 4096, M = BATCH * SEQ;
constexpr int NH = 4;
constexpr int N_INX = 3328;
constexpr int F = 2816, F2 = 5632;
constexpr float LN_EPS = 1e-5f;
constexpr float DN_ALPHA = 1.189207115002721f;
constexpr float LAMBDA_INIT = 0.2f;
constexpr float QSCALE = 0.125f * 1.4426950408889634f;

constexpr size_t MiB = 1u << 20;
constexpr size_t WS_CTL = 0;
constexpr size_t WS_ADA = 1 * MiB;
constexpr size_t WS_STATS = 1 * MiB + 256 * 1024;
constexpr size_t WS_COS = 2 * MiB, WS_SIN = 4 * MiB;
constexpr size_t WS_WIN = 6 * MiB;
constexpr size_t WS_WOUT = 13 * MiB;
constexpr size_t WS_WUP = 15 * MiB;
constexpr size_t WS_WDOWN = 26 * MiB;
constexpr size_t WS_XN = 32 * MiB + 4096;
constexpr size_t WS_BIG = 65 * MiB;
constexpr size_t WS_DQ = WS_BIG, WS_DK = WS_BIG + 16 * MiB, WS_DV = WS_BIG + 32 * MiB;
constexpr size_t WS_GQ = WS_BIG + 48 * MiB, WS_GK = WS_BIG + 56 * MiB;
constexpr size_t WS_GV = WS_BIG + 64 * MiB, WS_GR = WS_BIG + 80 * MiB;
constexpr size_t WS_GLOG = WS_BIG + 96 * MiB;
constexpr size_t WS_MIX = WS_BIG + 112 * MiB;
constexpr size_t WS_GLU = WS_BIG + 144 * MiB;
constexpr size_t WS_ACT = WS_BIG;
constexpr int XL_OFF = 136192;
constexpr size_t WS_UPH = WS_BIG;
constexpr size_t WS_ACTH = WS_BIG + 88 * MiB;
constexpr size_t WS_END = 256 * MiB;

struct Params {
    const float* x; const float* c; const int* pos; const float* ln_in_g; const float* ln_in_b;
    const float* w_ada; const float* b_ada; const float* w_in;
    const float* lq1; const float* lk1; const float* lq2; const float* lk2;
    const float* diff_norm_w; const float* w_gate_up; const float* b_gate; const float* gla_norm_w;
    const float* w_out; const float* ln_attn_g; const float* ln_attn_b;
    const float* w_up; const float* conv_w; const float* conv_b; const float* w_down;
    const float* ln_ffn_g; const float* ln_ffn_b;
    float* out; unsigned char* ws;
};

__device__ __forceinline__ unsigned f2bf(float f) { unsigned u = __builtin_bit_cast(unsigned, f); return (u + 0x7fffu + ((u >> 16) & 1u)) >> 16; }
__device__ __forceinline__ unsigned pk2(float lo, float hi) { return f2bf(lo) | (f2bf(hi) << 16); }
typedef float f32x2_t __attribute__((ext_vector_type(2)));
typedef __bf16 bf16x2_t __attribute__((ext_vector_type(2)));
__device__ __forceinline__ unsigned cvtpk(float lo, float hi) { f32x2_t v = {lo, hi}; bf16x2_t b = __builtin_convertvector(v, bf16x2_t); return __builtin_bit_cast(unsigned, b); }
__device__ __forceinline__ float bf2f(unsigned short b) { return __builtin_bit_cast(float, (unsigned)b << 16); }
__device__ __forceinline__ float bflo(unsigned w) { return __builtin_bit_cast(float, w << 16); }
__device__ __forceinline__ float bfhi(unsigned w) { return __builtin_bit_cast(float, w & 0xffff0000u); }
__device__ __forceinline__ float wave_sum(float v) {
#pragma unroll
    for (int o = 1; o < 64; o <<= 1) v += __shfl_xor(v, o);
    return v;
}
__device__ __forceinline__ float silu_f(float v) { return v / (1.0f + __expf(-v)); }
__device__ __forceinline__ float lambda_full(const Params& p) {
    float s1 = 0.f, s2 = 0.f;
    for (int i = 0; i < 64; ++i) { s1 += p.lq1[i] * p.lk1[i]; s2 += p.lq2[i] * p.lk2[i]; }
    return expf(s1) - expf(s2) + LAMBDA_INIT;
}

__device__ void phase_ada(const Params& p, float* smem, int bid, int nb) {
    float* ada = (float*)(p.ws + WS_ADA);
    const int t = threadIdx.x, nt = blockDim.x, cgp = t & 7, kl = t >> 3, nkl = nt >> 3;
    for (int item = bid; item < 6144 / 32; item += nb) {
        const int n0 = item * 32;
        float acc[4][4];
#pragma unroll
        for (int b = 0; b < 4; ++b)
#pragma unroll
            for (int j = 0; j < 4; ++j) acc[b][j] = 0.f;
        for (int k = kl; k < D; k += nkl) {
            const f32x4 w = *(const f32x4*)(p.w_ada + (size_t)k * 6144 + n0 + 4 * cgp);
#pragma unroll
            for (int b = 0; b < 4; ++b) { const float ca = silu_f(p.c[b * D + k]);
#pragma unroll
                for (int j = 0; j < 4; ++j) acc[b][j] += ca * w[j]; }
        }
        __syncthreads();
#pragma unroll
        for (int b = 0; b < 4; ++b)
#pragma unroll
            for (int j = 0; j < 4; ++j) smem[(kl * 32 + 4 * cgp + j) * 4 + b] = acc[b][j];
        __syncthreads();
        if (t < 128) { const int col = t & 31, b = t >> 5; float s = 0.f;
            for (int q = 0; q < nkl; ++q) s += smem[(q * 32 + col) * 4 + b];
            ada[b * 6144 + n0 + col] = s + p.b_ada[n0 + col]; }
    }
}

__device__ __forceinline__ void wprep_tile(const Params& p, float* tile  , int kind, int tn, int tk) {
    const int t = threadIdx.x, nt = blockDim.x, tx = t & 63, ty = t >> 6, nty = nt >> 6;
    const float* W; int N, K; bf16_t* WT;
    if (kind == 0) { W = p.w_in; N = 3088; K = D; WT = (bf16_t*)(p.ws + WS_WIN); }
    else if (kind == 1) { W = p.w_out; N = D; K = D; WT = (bf16_t*)(p.ws + WS_WOUT); }
    else if (kind == 2) { W = p.w_up; N = F2; K = D; WT = (bf16_t*)(p.ws + WS_WUP); }
    else { W = p.w_down; N = D; K = F; WT = (bf16_t*)(p.ws + WS_WDOWN); }
    const int n0 = tn * 64, k0 = tk * 64, np = n0 + tx;
    __syncthreads();
    if (kind == 0 && n0 >= 3072) {
        const int j = np - 3072;
        float g[16];
#pragma unroll
        for (int r = 0; r < 16; ++r) g[r] = p.w_gate_up[r * 256 + j];
        for (int kk = ty; kk < 64; kk += nty) { const float* wr = W + (size_t)(k0 + kk) * N + 3072; float s = 0.f;
#pragma unroll
            for (int r = 0; r < 16; ++r) s += wr[r] * g[r];
            tile[kk * 65 + tx] = s; }
    } else {
        int src;
        if (kind == 0) { if (np < 1024) { const int pp = np & 63; src = (np & ~63) + (pp >> 1) + 32 * (pp & 1); } else src = np; }
        else if (kind == 2) { const int pn = np >> 8, w = np & 255; src = (w < 128) ? (128 * pn + w) : (F + 128 * pn + (w - 128)); }
        else src = np;
        for (int kk = ty; kk < 64; kk += nty) tile[kk * 65 + tx] = W[(size_t)(k0 + kk) * N + src];
    }
    __syncthreads();
    for (int nn = ty; nn < 64; nn += nty) WT[(size_t)(n0 + nn) * K + k0 + tx] = (bf16_t)f2bf(tile[tx * 65 + nn]);
}
__device__ void phase_wprep(const Params& p, float* smem, int bid, int nb) {
    constexpr int T0 = (N_INX / 64) * (D / 64), T1 = (D / 64) * (D / 64), T2 = (F2 / 64) * (D / 64), T3 = (D / 64) * (F / 64);
    for (int it = bid; it < T0 + T1 + T2 + T3; it += nb) {
        int r = it;
        if (r < T0) { wprep_tile(p, smem, 0, r / (D / 64), r % (D / 64)); continue; } r -= T0;
        if (r < T1) { wprep_tile(p, smem, 1, r / (D / 64), r % (D / 64)); continue; } r -= T1;
        if (r < T2) { wprep_tile(p, smem, 2, r / (D / 64), r % (D / 64)); continue; } r -= T2;
        wprep_tile(p, smem, 3, r / (F / 64), r % (F / 64));
    }
}

__device__ void phase_rope(const Params& p, int bid, int nb) {
    float* COS = (float*)(p.ws + WS_COS); float* SIN = (float*)(p.ws + WS_SIN);
    for (int e = bid * blockDim.x + threadIdx.x; e < M * 32; e += nb * blockDim.x) {
        const int m = e >> 5, i = e & 31;
        double inv = 1.0; const double r = 0.74989420933245582730;
        for (int q = 0; q < i; ++q) inv *= r;
        const float invf = (float)inv;
        const double a = (double)((float)p.pos[m] * invf);
        const double qd = __builtin_rint(a * 0.63661977236758134308);
        const double rr = __builtin_fma(-qd, 1.57079632679489661923, a);
        const float x = (float)rr, x2 = x * x;
        const float s = x * (1.f + x2 * (-1.f / 6.f + x2 * (1.f / 120.f + x2 * (-1.f / 5040.f + x2 * (1.f / 362880.f)))));
        const float cc = 1.f + x2 * (-0.5f + x2 * (1.f / 24.f + x2 * (-1.f / 720.f + x2 * (1.f / 40320.f + x2 * (-1.f / 3628800.f)))));
        const int qi = (int)((long long)qd & 3);
        float co, si;
        if (qi == 0) { co = cc; si = s; } else if (qi == 1) { co = -s; si = cc; } else if (qi == 2) { co = -cc; si = -s; } else { co = s; si = -cc; }
        COS[e] = co; SIN[e] = si;
    }
}

__device__ __forceinline__ void ln_stats(const f32x4 (&v)[4], float& mean, float& rstd) {
    float s = 0.f;
#pragma unroll
    for (int j = 0; j < 4; ++j) s += (v[j].x + v[j].y) + (v[j].z + v[j].w);
    mean = wave_sum(s) * (1.f / D); float s2 = 0.f;
#pragma unroll
    for (int j = 0; j < 4; ++j) { const f32x4 d = v[j] - mean; s2 += (d.x * d.x + d.y * d.y) + (d.z * d.z + d.w * d.w); }
    rstd = 1.0f / sqrtf(wave_sum(s2) * (1.f / D) + LN_EPS);
}
__device__ void phase_ln_in(const Params& p, int bid, int nb) {
    const float* ada = (const float*)(p.ws + WS_ADA); float* stats = (float*)(p.ws + WS_STATS); bf16_t* XN = (bf16_t*)(p.ws + WS_XN);
    const int lane = threadIdx.x & 63, wpb = blockDim.x >> 6, gw = bid * wpb + (threadIdx.x >> 6), ngw = nb * wpb;
    for (int m = gw; m < M; m += ngw) {
        const int b = m / SEQ;
        const f32x4* xr = (const f32x4*)(p.x + (size_t)m * D) + lane;
        f32x4 v[4];
#pragma unroll
        for (int j = 0; j < 4; ++j) v[j] = xr[64 * j];
        float mean, rstd; ln_stats(v, mean, rstd);
        if (lane == 0) { stats[2 * m] = mean; stats[2 * m + 1] = rstd; }
        u32x2* o8 = (u32x2*)(XN + (size_t)m * D) + lane;
#pragma unroll
        for (int j = 0; j < 4; ++j) {
            const int col = 4 * lane + 256 * j;
            const f32x4 g = *(const f32x4*)(p.ln_in_g + col), bb = *(const f32x4*)(p.ln_in_b + col);
            const f32x4 sh = *(const f32x4*)(ada + b * 6144 + col), sc = *(const f32x4*)(ada + b * 6144 + 1024 + col);
            const f32x4 h = (v[j] - mean) * rstd * g + bb;
            const f32x4 u = h * (1.0f + sc) + sh;
            u32x2 w; w.x = pk2(u.x, u.y); w.y = pk2(u.z, u.w); o8[64 * j] = w;
        }
    }
}
__device__ void phase_ln_rows(const Params& p, float* R, const float* g, const float* bb, bf16_t* XN2, int sh_off, int sc_off, int bid, int nb) {
    const float* ada = (const float*)(p.ws + WS_ADA);
    const int lane = threadIdx.x & 63, wpb = blockDim.x >> 6, gw = bid * wpb + (threadIdx.x >> 6), ngw = nb * wpb;
    for (int m = gw; m < M; m += ngw) {
        const int b = m / SEQ;
        f32x4* xr = (f32x4*)(R + (size_t)m * D) + lane;
        f32x4 v[4];
#pragma unroll
        for (int j = 0; j < 4; ++j) v[j] = xr[64 * j];
        float mean, rstd; ln_stats(v, mean, rstd);
#pragma unroll
        for (int j = 0; j < 4; ++j) {
            const int col = 4 * lane + 256 * j;
            const f32x4 gg = *(const f32x4*)(g + col), b4 = *(const f32x4*)(bb + col);
            const f32x4 h = (v[j] - mean) * rstd * gg + b4;
            xr[64 * j] = h;
            if (XN2) {
                const f32x4 sh = *(const f32x4*)(ada + b * 6144 + sh_off + col), sc = *(const f32x4*)(ada + b * 6144 + sc_off + col);
                const f32x4 u = h * (1.0f + sc) + sh;
                u32x2 w; w.x = pk2(u.x, u.y); w.y = pk2(u.z, u.w); ((u32x2*)(XN2 + (size_t)m * D) + lane)[64 * j] = w;
            }
        }
    }
}

template <class Epi>
__device__ void gemm_simple(const bf16_t* A, int lda, const bf16_t* Bt, int ldb, int Mrows, int N, int K, const Epi& epi, int bid, int nb) {
    const int lane = threadIdx.x & 63, fr = lane & 15, fq = lane >> 4, wpb = blockDim.x >> 6, gw = bid * wpb + (threadIdx.x >> 6), ngw = nb * wpb;
    const int ntn = N / 32, ntiles = (Mrows / 32) * ntn;
    for (int tile = gw; tile < ntiles; tile += ngw) {
        const int m0 = (tile / ntn) * 32, n0 = (tile % ntn) * 32;
        f32x4 acc[2][2];
#pragma unroll
        for (int i = 0; i < 2; ++i)
#pragma unroll
            for (int j = 0; j < 2; ++j) acc[i][j] = (f32x4){0.f, 0.f, 0.f, 0.f};
        const bf16_t* ap = A + (size_t)(m0 + fr) * lda + 8 * fq;
        const bf16_t* bp = Bt + (size_t)(n0 + fr) * ldb + 8 * fq;
#pragma unroll 4
        for (int k0 = 0; k0 < K; k0 += 32) {
            bf16x8 a[2], b[2];
            a[0] = *(const bf16x8*)(ap + k0); a[1] = *(const bf16x8*)(ap + (size_t)16 * lda + k0);
            b[0] = *(const bf16x8*)(bp + k0); b[1] = *(const bf16x8*)(bp + (size_t)16 * ldb + k0);
#pragma unroll
            for (int i = 0; i < 2; ++i)
#pragma unroll
                for (int j = 0; j < 2; ++j) acc[i][j] = __builtin_amdgcn_mfma_f32_16x16x32_bf16(b[j], a[i], acc[i][j], 0, 0, 0);
        }
#pragma unroll
        for (int i = 0; i < 2; ++i)
#pragma unroll
            for (int j = 0; j < 2; ++j) epi(m0 + 16 * i + fr, n0 + 16 * j + 4 * fq, acc[i][j]);
    }
}

struct EpiIn {
    unsigned char* ws; const float* b_gate;
    __device__ __forceinline__ void operator()(int row, int col0, f32x4 v) const {
        if (col0 < 1024) {
            const int i0 = (col0 & 63) >> 1;
            const float* COS = (const float*)(ws + WS_COS) + (size_t)row * 32 + i0; const float* SIN = (const float*)(ws + WS_SIN) + (size_t)row * 32 + i0;
            const float c0 = COS[0], c1 = COS[1], s0 = SIN[0], s1 = SIN[1];
            float o0 = v[0] * c0 - v[1] * s0, o1 = v[1] * c0 + v[0] * s0, o2 = v[2] * c1 - v[3] * s1, o3 = v[3] * c1 + v[2] * s1;
            bf16_t* dst;
            if (col0 < 512) { o0 *= QSCALE; o1 *= QSCALE; o2 *= QSCALE; o3 *= QSCALE; dst = (bf16_t*)(ws + WS_DQ) + (size_t)row * 512 + col0; }
            else dst = (bf16_t*)(ws + WS_DK) + (size_t)row * 512 + (col0 - 512);
            u32x2 w; w.x = pk2(o0, o1); w.y = pk2(o2, o3); *(u32x2*)dst = w;
        } else if (col0 < 3072) {
            bf16_t* dst;
            if (col0 < 1536) dst = (bf16_t*)(ws + WS_DV) + (size_t)row * 512 + (col0 - 1024);
            else if (col0 < 1792) { v = v * 0.125f; dst = (bf16_t*)(ws + WS_GQ) + (size_t)row * 256 + (col0 - 1536); }
            else if (col0 < 2048) dst = (bf16_t*)(ws + WS_GK) + (size_t)row * 256 + (col0 - 1792);
            else if (col0 < 2560) dst = (bf16_t*)(ws + WS_GV) + (size_t)row * 512 + (col0 - 2048);
            else { v = (f32x4){silu_f(v[0]), silu_f(v[1]), silu_f(v[2]), silu_f(v[3])}; dst = (bf16_t*)(ws + WS_GR) + (size_t)row * 512 + (col0 - 2560); }
            u32x2 w; w.x = pk2(v[0], v[1]); w.y = pk2(v[2], v[3]); *(u32x2*)dst = w;
        } else {
            const int j = col0 - 3072; f32x4 o;
#pragma unroll
            for (int q = 0; q < 4; ++q) { const float z = v[q] + b_gate[j + q]; o[q] = (fminf(z, 0.f) - __logf(1.0f + __expf(-fabsf(z)))) * (1.0f / 16.0f); }
            *(f32x4*)((float*)(ws + WS_GLOG) + (size_t)row * 256 + j) = o;
        }
    }
};
struct EpiOut {
    const Params* p;
    __device__ __forceinline__ void operator()(int row, int col0, f32x4 v) const {
        const float* ada = (const float*)(p->ws + WS_ADA); const float* stats = (const float*)(p->ws + WS_STATS);
        const int b = row / SEQ; const float mean = stats[2 * row], rstd = stats[2 * row + 1];
        const f32x4 xv = *(const f32x4*)(p->x + (size_t)row * D + col0), g = *(const f32x4*)(p->ln_in_g + col0), bb = *(const f32x4*)(p->ln_in_b + col0);
        const f32x4 gt = *(const f32x4*)(ada + b * 6144 + 2048 + col0);
        const f32x4 h0 = (xv - mean) * rstd * g + bb;
        *(f32x4*)(p->out + (size_t)row * D + col0) = h0 * DN_ALPHA + (1.0f + gt) * v;
    }
};
struct EpiUpRaw {
    bf16_t* UP; int row_off;
    __device__ __forceinline__ void operator()(int row, int col0, f32x4 v) const {
        u32x2 w; w.x = pk2(v[0], v[1]); w.y = pk2(v[2], v[3]); *(u32x2*)(UP + (size_t)row * F2 + col0) = w;
    }
};
struct EpiDown {
    const Params* p; int row_off;
    __device__ __forceinline__ void operator()(int row, int col0, f32x4 v) const {
        const float* ada = (const float*)(p->ws + WS_ADA);
        const int grow = row + row_off, b = grow / SEQ;
        const f32x4 gt = *(const f32x4*)(ada + b * 6144 + 5120 + col0);
        f32x4* o = (f32x4*)(p->out + (size_t)grow * D + col0);
        *o = (*o) * DN_ALPHA + (1.0f + gt) * v;
    }
};


namespace pg8 {
#define PG8_LAS __attribute__((address_space(3)))
typedef unsigned short bf16_t;
typedef short bf16x8 __attribute__((ext_vector_type(8)));
typedef float f32x4 __attribute__((ext_vector_type(4)));
typedef unsigned u32x4 __attribute__((ext_vector_type(4)));
constexpr int BM = 256, BK = 64, HALF = 128, HTB = HALF * BK * 2  , STAGE_BYTES = 8 * HTB, NXCD = 8, WGM = 8;

__host__ __device__ __forceinline__ int lds_byte(int r, int c) { const int st = (r >> 4) * 2 + (c >> 5), rr = r & 15, cc = c & 31, ob = rr * 64 + cc * 2; return st * 1024 + (ob ^ (((ob >> 9) & 1) << 5)); }
__host__ __device__ __forceinline__ void stage_rc(int b, int& R, int& C) { const int st = b / 1024, sb = b % 1024, swz = sb ^ (((sb >> 9) & 1) << 5); R = (st >> 1) * 16 + swz / 64; C = (st & 1) * 32 + (swz % 64) / 2; }
__host__ __device__ __forceinline__ int perm32(int rho) { const int n = rho >> 4, i = rho & 15; return 8 * (i >> 2) + 4 * n + (i & 3); }

struct Unit { int pm, pn; };
struct Gemm { const bf16_t* A; const bf16_t* Bt; int M, N, K; int a_rows; };

struct StaticOrder {
    int nM, nN, nwg, G, c;
    __host__ __device__ void init(int M, int N, int G_, int c_) { nM = M / BM; nN = N / BM; nwg = nM * nN; G = G_; c = c_; }
    __host__ __device__ bool next(int i, Unit& u) const {
        const long L = (long)i * G + c; if (L >= nwg) return false;
        int wgid = (int)L; { const int q = nwg / NXCD, r = nwg % NXCD, xcd = wgid % NXCD, off = wgid / NXCD; wgid = (xcd < r ? xcd * (q + 1) : r * (q + 1) + (xcd - r) * q) + off; }
        const int nig = WGM * nN, gid = wgid / nig, fm = gid * WGM, gsz = (nM - fm) < WGM ? (nM - fm) : WGM;
        u.pm = fm + ((wgid % nig) % gsz); u.pn = (wgid % nig) / gsz; return true;
    }
    __device__ __forceinline__ void a_ready(const Unit&) const {}
    __device__ __forceinline__ void done(const Unit&) const {}
};
__device__ __forceinline__ unsigned cvt_pk_bf16(float lo, float hi) { unsigned r; asm volatile("v_cvt_pk_bf16_f32 %0, %1, %2" : "=v"(r) : "v"(lo), "v"(hi)); return r; }
template <class Epi, class Sched, bool ALIGN_EPI = false, bool SP2 = false>
__device__ __forceinline__ void gemm_phase(PG8_LAS unsigned char* lds, const Gemm g, const Sched& S, const Epi& E) {
    int tid_ = threadIdx.x; asm volatile("" : "+v"(tid_));
    const int tid = tid_, wid = __builtin_amdgcn_readfirstlane(tid >> 6), lane = tid & 63, wr = wid >> 2, wc = wid & 3, fr = lane & 15, fq = lane >> 4;
    const int K = g.K, nt = K / BK;
    unsigned voffA[2], voffA1[2], voffB[2];
#pragma unroll
    for (int i = 0; i < 2; ++i) { int R, C; stage_rc(tid * 16 + i * 8192, R, C); const int Rb = Epi::PERM ? ((R & ~31) + perm32(R & 31)) : R;
        if constexpr (Epi::APERM) {
            const int Ra = 128 * (R >> 6) + 8 * (R & 15) + ((R >> 4) & 3); voffA[i] = (unsigned)(Ra * K + C) * 2u; voffA1[i] = (unsigned)((Ra + 4) * K + C) * 2u; }
        else { voffA[i] = (unsigned)(R * K + C) * 2u; voffA1[i] = (unsigned)((R + HALF) * K + C) * 2u; }
        voffB[i] = (unsigned)(Rb * K + C) * 2u; }
    const size_t kstep = (size_t)(BK * 2);
    const size_t hstep = (size_t)HALF * K * 2;
    const size_t tstep = 2 * hstep;
    const size_t tstepA = (size_t)g.a_rows * K * 2;
    const unsigned ldsw = (unsigned)wid * 1024u;
    const int aoff = lds_byte(wr * 64 + fr, fq * 8), boff = lds_byte(wc * 32 + fr, fq * 8);
#define PG8_SA(b, h) (((b) * 2 + (h)) * HTB)
#define PG8_SB(b, h) ((4 + (b) * 2 + (h)) * HTB)
#define PG8_STAGE(bufoff, gbase, voff) do { _Pragma("unroll") for (int _i = 0; _i < 2; ++_i) \
        __builtin_amdgcn_global_load_lds((const unsigned*)((const char*)(gbase) + (voff)[_i]), (PG8_LAS unsigned*)(lds + (bufoff) + ldsw + _i * 8192), 16, 0, 0); } while (0)
#define PG8_LDA(dst, b, h) do { _Pragma("unroll") for (int m = 0; m < 4; ++m) _Pragma("unroll") for (int k = 0; k < 2; ++k) dst[m][k] = *(const PG8_LAS bf16x8*)(lds + PG8_SA(b, h) + aoff + m * 2048 + k * 1024); } while (0)
#define PG8_LDB(dst, b, h) do { _Pragma("unroll") for (int n = 0; n < 2; ++n) _Pragma("unroll") for (int k = 0; k < 2; ++k) dst[n][k] = *(const PG8_LAS bf16x8*)(lds + PG8_SB(b, h) + boff + n * 2048 + k * 1024); } while (0)
#define PG8_MMA(ai, bj, At, Bt) do { __builtin_amdgcn_s_setprio(1); _Pragma("unroll") for (int m = 0; m < 4; ++m) _Pragma("unroll") for (int n = 0; n < 2; ++n) _Pragma("unroll") for (int k = 0; k < 2; ++k) \
        acc[ai][bj][m][n] = __builtin_amdgcn_mfma_f32_16x16x32_bf16(Bt[n][k], At[m][k], acc[ai][bj][m][n], 0, 0, 0); __builtin_amdgcn_s_setprio(0); } while (0)
#define PG8_WAIT_V(n) asm volatile("s_waitcnt vmcnt(" #n ")" ::: "memory")
#define PG8_WAIT_L(n) asm volatile("s_waitcnt lgkmcnt(" #n ")" ::: "memory")
#define PG8_BAR __builtin_amdgcn_s_barrier()
#define PG8_SCHED __builtin_amdgcn_sched_barrier(0)
    Unit cur, nxt; int ui = 0;
    if (!S.next(0, cur)) return;
    f32x4 acc[2][2][4][2];
#pragma unroll
    for (int a = 0; a < 2; ++a)
#pragma unroll
        for (int b = 0; b < 2; ++b)
#pragma unroll
            for (int m = 0; m < 4; ++m)
#pragma unroll
                for (int n = 0; n < 2; ++n) acc[a][b][m][n] = (f32x4){0.f, 0.f, 0.f, 0.f};
    bf16x8 At[4][2], B0[2][2], B1[2][2];
    const char* cA = (const char*)g.A + (size_t)cur.pm * tstepA; const char* cB = (const char*)g.Bt + (size_t)cur.pn * tstep;
    S.a_ready(cur);
    if constexpr (SP2) {
        PG8_STAGE(PG8_SB(0, 0), cB, voffB); PG8_STAGE(PG8_SB(0, 1), cB + hstep, voffB); PG8_STAGE(PG8_SA(0, 0), cA, voffA); PG8_STAGE(PG8_SA(0, 1), cA, voffA1);
        if (wr == 1) PG8_BAR;
        PG8_WAIT_V(2); PG8_BAR;
        PG8_STAGE(PG8_SB(1, 0), cB + kstep, voffB); PG8_STAGE(PG8_SA(1, 0), cA + kstep, voffA); PG8_STAGE(PG8_SB(1, 1), cB + hstep + kstep, voffB);
        PG8_WAIT_V(6); PG8_BAR;
    } else {
        PG8_STAGE(PG8_SB(0, 0), cB, voffB); PG8_STAGE(PG8_SA(0, 0), cA, voffA); PG8_STAGE(PG8_SB(0, 1), cB + hstep, voffB); PG8_STAGE(PG8_SA(0, 1), cA, voffA1);
        if (wr == 1) PG8_BAR;
        PG8_WAIT_V(4); PG8_BAR;
        PG8_STAGE(PG8_SB(1, 0), cB + kstep, voffB); PG8_STAGE(PG8_SA(1, 0), cA + kstep, voffA); PG8_STAGE(PG8_SB(1, 1), cB + hstep + kstep, voffB);
        PG8_WAIT_V(6); PG8_BAR;
    }
    for (;;) {
        const bool has_next = S.next(ui + 1, nxt);
        const char* nA = has_next ? (const char*)g.A + (size_t)nxt.pm * tstepA : cA; const char* nB = has_next ? (const char*)g.Bt + (size_t)nxt.pn * tstep : cB;
        for (int t = 0; t < nt; t += 2) {
            const bool last = (t == nt - 2);
            const char* a1 = cA + (size_t)(t + 1) * kstep;
            const char* a2 = last ? nA : cA + (size_t)(t + 2) * kstep; const char* b2 = last ? nB : cB + (size_t)(t + 2) * kstep;
            const char* a3 = a2 + kstep; const char* b3 = b2 + kstep;
            if (last && has_next) S.a_ready(nxt);
            if constexpr (SP2) {
            PG8_LDB(B0, 0, 0); PG8_LDB(B1, 0, 1); PG8_SCHED; PG8_LDA(At, 0, 0); PG8_STAGE(PG8_SA(1, 1), a1, voffA1);
            PG8_WAIT_V(8); PG8_WAIT_L(0); PG8_BAR; PG8_MMA(0, 0, At, B0); PG8_MMA(0, 1, At, B1); PG8_BAR; PG8_SCHED;
            PG8_LDA(At, 0, 1); PG8_STAGE(PG8_SB(0, 0), b2, voffB); PG8_STAGE(PG8_SB(0, 1), b2 + hstep, voffB); PG8_STAGE(PG8_SA(0, 0), a2, voffA);
            PG8_WAIT_V(8); PG8_WAIT_L(0); PG8_BAR; PG8_MMA(1, 0, At, B0); PG8_MMA(1, 1, At, B1); PG8_BAR; PG8_SCHED;
            PG8_LDB(B0, 1, 0); PG8_LDB(B1, 1, 1); PG8_SCHED; PG8_LDA(At, 1, 0); PG8_STAGE(PG8_SA(0, 1), a2, voffA1);
            PG8_WAIT_V(8); PG8_WAIT_L(0); PG8_BAR; PG8_MMA(0, 0, At, B0); PG8_MMA(0, 1, At, B1); PG8_BAR; PG8_SCHED;
            PG8_LDA(At, 1, 1); PG8_STAGE(PG8_SB(1, 0), b3, voffB); PG8_STAGE(PG8_SB(1, 1), b3 + hstep, voffB); PG8_STAGE(PG8_SA(1, 0), a3, voffA);
            PG8_WAIT_V(8); PG8_WAIT_L(0); PG8_BAR; PG8_MMA(1, 0, At, B0); PG8_MMA(1, 1, At, B1); PG8_BAR; PG8_SCHED;
            } else {
            PG8_LDB(B0, 0, 0); PG8_SCHED; PG8_LDA(At, 0, 0); PG8_STAGE(PG8_SA(1, 1), a1, voffA1);
            PG8_WAIT_L(8); PG8_BAR; PG8_WAIT_L(0); PG8_MMA(0, 0, At, B0); PG8_BAR; PG8_SCHED;
            PG8_LDB(B1, 0, 1); PG8_STAGE(PG8_SB(0, 0), b2, voffB);
            PG8_BAR; PG8_WAIT_L(0); PG8_MMA(0, 1, At, B1); PG8_BAR;
            PG8_LDA(At, 0, 1); PG8_STAGE(PG8_SA(0, 0), a2, voffA);
            PG8_BAR; PG8_WAIT_L(0); PG8_MMA(1, 0, At, B0); PG8_BAR; PG8_SCHED;
            PG8_STAGE(PG8_SB(0, 1), b2 + hstep, voffB);
            PG8_WAIT_V(6); PG8_BAR; PG8_MMA(1, 1, At, B1); PG8_BAR;
            PG8_LDB(B0, 1, 0); PG8_SCHED; PG8_LDA(At, 1, 0); PG8_STAGE(PG8_SA(0, 1), a2, voffA1);
            PG8_WAIT_L(8); PG8_BAR; PG8_WAIT_L(0); PG8_MMA(0, 0, At, B0); PG8_BAR; PG8_SCHED;
            PG8_LDB(B1, 1, 1); PG8_STAGE(PG8_SB(1, 0), b3, voffB);
            PG8_BAR; PG8_WAIT_L(0); PG8_MMA(0, 1, At, B1); PG8_BAR;
            PG8_LDA(At, 1, 1); PG8_STAGE(PG8_SA(1, 0), a3, voffA);
            PG8_BAR; PG8_WAIT_L(0); PG8_MMA(1, 0, At, B0); PG8_BAR; PG8_SCHED;
            PG8_STAGE(PG8_SB(1, 1), b3 + hstep, voffB);
            PG8_WAIT_V(6); PG8_BAR; PG8_MMA(1, 1, At, B1); PG8_BAR;
            }
        }
        if constexpr (ALIGN_EPI) { if (wr == 0) PG8_BAR; }
        if constexpr (!Epi::AFTER_DRAIN) { E(acc, cur, wr, wc, fr, fq); S.done(cur); }
        if (!has_next) break;
#pragma unroll
        for (int a = 0; a < 2; ++a)
#pragma unroll
            for (int b = 0; b < 2; ++b)
#pragma unroll
                for (int m = 0; m < 4; ++m)
#pragma unroll
                    for (int n = 0; n < 2; ++n) acc[a][b][m][n] = (f32x4){0.f, 0.f, 0.f, 0.f};
        cur = nxt; cA = nA; cB = nB; ++ui;
        if constexpr (ALIGN_EPI) { if (wr == 1) PG8_BAR; }
    }
    PG8_WAIT_V(0);
    if constexpr (!ALIGN_EPI) { if (wr == 0) PG8_BAR; }
    PG8_BAR;
    if constexpr (Epi::AFTER_DRAIN) { E.fused(acc, cur, wr, wc, fr, fq, lds, wid, lane); S.done(cur); }
#undef PG8_SA
#undef PG8_SB
#undef PG8_STAGE
#undef PG8_LDA
#undef PG8_LDB
#undef PG8_MMA
#undef PG8_WAIT_V
#undef PG8_WAIT_L
#undef PG8_BAR
#undef PG8_SCHED
}
}

struct EpiInP {
    static constexpr bool PERM = true, AFTER_DRAIN = false, APERM = false;
    unsigned char* ws; const float* b_gate;
    __device__ __forceinline__ void operator()(const f32x4 (&acc)[2][2][4][2], const pg8::Unit& u, int wr, int wc, int fr, int fq) const {
        const int pn = u.pn, cw = wc * 32 + 8 * fq, rowb = u.pm * 256 + wr * 64 + fr;
        if (pn < 4) {
            const int i0 = (cw & 63) >> 1;
            bf16_t* base = (bf16_t*)(ws + (pn < 2 ? WS_DQ : WS_DK)) + (pn & 1) * 256 + cw;
            const float sc = pn < 2 ? QSCALE : 1.0f;
            const float* COS = (const float*)(ws + WS_COS) + i0; const float* SIN = (const float*)(ws + WS_SIN) + i0;
#pragma unroll
            for (int ai = 0; ai < 2; ++ai)
#pragma unroll
                for (int m = 0; m < 4; ++m) { const int row = rowb + ai * 128 + m * 16;
                    const f32x4 c = *(const f32x4*)(COS + (size_t)row * 32), s = *(const f32x4*)(SIN + (size_t)row * 32);
#pragma unroll
                    for (int bj = 0; bj < 2; ++bj) { const f32x4 v0 = acc[ai][bj][m][0], v1 = acc[ai][bj][m][1]; u32x4 w;
                        w.x = cvtpk((v0[0] * c[0] - v0[1] * s[0]) * sc, (v0[1] * c[0] + v0[0] * s[0]) * sc);
                        w.y = cvtpk((v0[2] * c[1] - v0[3] * s[1]) * sc, (v0[3] * c[1] + v0[2] * s[1]) * sc);
                        w.z = cvtpk((v1[0] * c[2] - v1[1] * s[2]) * sc, (v1[1] * c[2] + v1[0] * s[2]) * sc);
                        w.w = cvtpk((v1[2] * c[3] - v1[3] * s[3]) * sc, (v1[3] * c[3] + v1[2] * s[3]) * sc);
                        *(u32x4*)(base + (size_t)row * 512 + bj * 128) = w; } }
        } else if (pn < 12) {
            bf16_t* base; int pitch; float mul = 1.0f; bool act = false;
            if (pn < 6) { base = (bf16_t*)(ws + WS_DV) + (pn - 4) * 256; pitch = 512; }
            else if (pn == 6) { base = (bf16_t*)(ws + WS_GQ); pitch = 256; mul = 0.125f; }
            else if (pn == 7) { base = (bf16_t*)(ws + WS_GK); pitch = 256; }
            else if (pn < 10) { base = (bf16_t*)(ws + WS_GV) + (pn - 8) * 256; pitch = 512; }
            else { base = (bf16_t*)(ws + WS_GR) + (pn - 10) * 256; pitch = 512; act = true; }
            base += cw;
#pragma unroll
            for (int ai = 0; ai < 2; ++ai)
#pragma unroll
                for (int m = 0; m < 4; ++m) { const int row = rowb + ai * 128 + m * 16;
#pragma unroll
                    for (int bj = 0; bj < 2; ++bj) { f32x4 v0 = acc[ai][bj][m][0] * mul, v1 = acc[ai][bj][m][1] * mul;
                        if (act) { v0 = (f32x4){silu_f(v0[0]), silu_f(v0[1]), silu_f(v0[2]), silu_f(v0[3])}; v1 = (f32x4){silu_f(v1[0]), silu_f(v1[1]), silu_f(v1[2]), silu_f(v1[3])}; }
                        u32x4 w; w.x = cvtpk(v0[0], v0[1]); w.y = cvtpk(v0[2], v0[3]); w.z = cvtpk(v1[0], v1[1]); w.w = cvtpk(v1[2], v1[3]);
                        *(u32x4*)(base + (size_t)row * pitch + bj * 128) = w; } }
        } else {
            float* base = (float*)(ws + WS_GLOG) + cw;
#pragma unroll
            for (int bj = 0; bj < 2; ++bj) { const f32x4 b0 = *(const f32x4*)(b_gate + bj * 128 + cw), b1 = *(const f32x4*)(b_gate + bj * 128 + cw + 4);
#pragma unroll
                for (int ai = 0; ai < 2; ++ai)
#pragma unroll
                    for (int m = 0; m < 4; ++m) { const int row = rowb + ai * 128 + m * 16; const f32x4 z0 = acc[ai][bj][m][0] + b0, z1 = acc[ai][bj][m][1] + b1; f32x4 o0, o1;
#pragma unroll
                        for (int q = 0; q < 4; ++q) { o0[q] = (fminf(z0[q], 0.f) - __logf(1.0f + __expf(-fabsf(z0[q])))) * (1.0f / 16.0f); o1[q] = (fminf(z1[q], 0.f) - __logf(1.0f + __expf(-fabsf(z1[q])))) * (1.0f / 16.0f); }
                        float* d = base + (size_t)row * 256 + bj * 128; *(f32x4*)d = o0; *(f32x4*)(d + 4) = o1; } }
        }
    }
};
struct EpiOutP {
    static constexpr bool PERM = false, AFTER_DRAIN = false, APERM = false;
    const Params* p;
    __device__ __forceinline__ void operator()(const f32x4 (&acc)[2][2][4][2], const pg8::Unit& u, int wr, int wc, int fr, int fq) const {
        const float* ada = (const float*)(p->ws + WS_ADA); const float* stats = (const float*)(p->ws + WS_STATS);
        const int rowb = u.pm * 256 + wr * 64 + fr, col0 = u.pn * 256 + wc * 32 + 4 * fq, b = (u.pm * 256) / SEQ;
        float mean[2][4], rstd[2][4];
#pragma unroll
        for (int ai = 0; ai < 2; ++ai)
#pragma unroll
            for (int m = 0; m < 4; ++m) { const int row = rowb + ai * 128 + m * 16; mean[ai][m] = stats[2 * row]; rstd[ai][m] = stats[2 * row + 1]; }
#pragma unroll
        for (int bj = 0; bj < 2; ++bj)
#pragma unroll
            for (int n = 0; n < 2; ++n) { const int col = col0 + bj * 128 + n * 16;
                const f32x4 g = *(const f32x4*)(p->ln_in_g + col), bb = *(const f32x4*)(p->ln_in_b + col), gt = 1.0f + *(const f32x4*)(ada + b * 6144 + 2048 + col);
#pragma unroll
                for (int ai = 0; ai < 2; ++ai)
#pragma unroll
                    for (int m = 0; m < 4; ++m) { const size_t off = (size_t)(rowb + ai * 128 + m * 16) * D + col;
                        const f32x4 xv = *(const f32x4*)(p->x + off); const f32x4 h0 = (xv - mean[ai][m]) * rstd[ai][m] * g + bb;
                        *(f32x4*)(p->out + off) = h0 * DN_ALPHA + gt * acc[ai][bj][m][n]; } }
    }
};
struct EpiUpRawP {
    static constexpr bool PERM = true, AFTER_DRAIN = false, APERM = false;
    bf16_t* UP;
    __device__ __forceinline__ void operator()(const f32x4 (&acc)[2][2][4][2], const pg8::Unit& u, int wr, int wc, int fr, int fq) const {
        const int rowb = u.pm * 256 + wr * 64 + fr; bf16_t* base = UP + u.pn * 256 + wc * 32 + 8 * fq;
#pragma unroll
        for (int ai = 0; ai < 2; ++ai)
#pragma unroll
            for (int m = 0; m < 4; ++m)
#pragma unroll
                for (int bj = 0; bj < 2; ++bj) { const f32x4 v0 = acc[ai][bj][m][0], v1 = acc[ai][bj][m][1];
                    u32x4 w; w.x = cvtpk(v0[0], v0[1]); w.y = cvtpk(v0[2], v0[3]); w.z = cvtpk(v1[0], v1[1]); w.w = cvtpk(v1[2], v1[3]);
                    *(u32x4*)(base + (size_t)(rowb + ai * 128 + m * 16) * F2 + bj * 128) = w; }
    }
};
struct EpiDownP {
    static constexpr bool PERM = false, AFTER_DRAIN = false, APERM = false;
    const Params* p; int row_off;
    __device__ __forceinline__ void operator()(const f32x4 (&acc)[2][2][4][2], const pg8::Unit& u, int wr, int wc, int fr, int fq) const {
        const float* ada = (const float*)(p->ws + WS_ADA);
        const int rowb = row_off + u.pm * 256 + wr * 64 + fr, col0 = u.pn * 256 + wc * 32 + 4 * fq, b = (row_off + u.pm * 256) / SEQ;
#pragma unroll
        for (int bj = 0; bj < 2; ++bj)
#pragma unroll
            for (int n = 0; n < 2; ++n) { const int col = col0 + bj * 128 + n * 16; const f32x4 gt = 1.0f + *(const f32x4*)(ada + b * 6144 + 5120 + col);
#pragma unroll
                for (int ai = 0; ai < 2; ++ai)
#pragma unroll
                    for (int m = 0; m < 4; ++m) { f32x4* o = (f32x4*)(p->out + (size_t)(rowb + ai * 128 + m * 16) * D + col); *o = (*o) * DN_ALPHA + gt * acc[ai][bj][m][n]; } }
    }
};
__device__ __forceinline__ float dpp_shr1(float v) { const int i = __builtin_bit_cast(int, v); return __builtin_bit_cast(float, __builtin_amdgcn_update_dpp(i, i, 0x111, 0xf, 0xf, false)); }
struct EpiUpConv {
    static constexpr bool PERM = true, AFTER_DRAIN = false, APERM = true;
    const Params* p; bf16_t* ACT; PG8_LAS float* xl;
    __device__ __forceinline__ void operator()(const f32x4 (&acc)[2][2][4][2], const pg8::Unit& u, int wr, int wc, int fr, int fq) const {
        const float* cw = p->conv_w; const float* cbias = p->conv_b;
        const int j0 = u.pn * 128 + wc * 32 + 8 * fq;
        PG8_LAS float* xs = xl + (wc * 4 + fq) * 32;
        if (wr == 0 && fr == 15) {
#pragma unroll
            for (int sl = 0; sl < 2; ++sl)
#pragma unroll
                for (int bj = 0; bj < 2; ++bj)
#pragma unroll
                    for (int n = 0; n < 2; ++n) *(PG8_LAS f32x4*)(xs + sl * 16 + bj * 8 + n * 4) = acc[1][bj][2 + sl][n];
        }
        asm volatile("s_waitcnt lgkmcnt(0)" ::: "memory"); __builtin_amdgcn_s_barrier(); asm volatile("" ::: "memory");
        const int rho0 = 128 * wr + 8 * fr, t0 = 254 * u.pm - 2 + rho0;
#pragma unroll
        for (int n = 0; n < 2; ++n) {
            const int ja = j0 + 4 * n;
            const f32x4 wa0 = *(const f32x4*)(cw + ja), wa1 = *(const f32x4*)(cw + F2 + ja), wa2 = *(const f32x4*)(cw + 2 * F2 + ja), ba = *(const f32x4*)(cbias + ja);
            const f32x4 wb0 = *(const f32x4*)(cw + F + ja), wb1 = *(const f32x4*)(cw + F2 + F + ja), wb2 = *(const f32x4*)(cw + 2 * F2 + F + ja), bb = *(const f32x4*)(cbias + F + ja);
            f32x4 am1, am2, bm1, bm2;
#pragma unroll
            for (int q = 0; q < 4; ++q) { am1[q] = dpp_shr1(acc[1][0][3][n][q]); am2[q] = dpp_shr1(acc[1][0][2][n][q]); bm1[q] = dpp_shr1(acc[1][1][3][n][q]); bm2[q] = dpp_shr1(acc[1][1][2][n][q]); }
            if (fr == 0 && wr == 1) { am2 = *(const PG8_LAS f32x4*)(xs + n * 4); bm2 = *(const PG8_LAS f32x4*)(xs + 8 + n * 4); am1 = *(const PG8_LAS f32x4*)(xs + 16 + n * 4); bm1 = *(const PG8_LAS f32x4*)(xs + 24 + n * 4); }
#pragma unroll
            for (int s = 0; s < 8; ++s) {
                const f32x4 xa = acc[s >> 2][0][s & 3][n], xb = acc[s >> 2][1][s & 3][n];
                const int t = t0 + s, sp = t & (SEQ - 1);
                const float f1 = sp >= 1 ? 1.f : 0.f, f2 = sp >= 2 ? 1.f : 0.f;
                const f32x4 ca = ba + wa2 * xa + (wa1 * am1) * f1 + (wa0 * am2) * f2;
                const f32x4 cb = bb + wb2 * xb + (wb1 * bm1) * f1 + (wb0 * bm2) * f2;
                float act[4];
#pragma unroll
                for (int q = 0; q < 4; ++q) act[q] = ca[q] * __builtin_amdgcn_rcpf(1.0f + __builtin_amdgcn_exp2f(-1.4426950408889634f * ca[q])) * cb[q];
                const unsigned w0 = cvtpk(act[0], act[1]), w1 = cvtpk(act[2], act[3]);
                if (rho0 + s >= 2 && t < M) *(u32x2*)(ACT + (size_t)t * F + ja) = (u32x2){w0, w1};
                am2 = am1; am1 = xa; bm2 = bm1; bm1 = xb;
            }
        }
    }
};
template <class Epi> __device__ __forceinline__ void gemm_pg8(unsigned char* lds, const bf16_t* A, const bf16_t* Bt, int Mrows, int N, int K, const Epi& e) {
    pg8::Gemm g{A, Bt, Mrows, N, K, 256}; pg8::StaticOrder S; S.init(Mrows, N, (int)gridDim.x, (int)blockIdx.x);
    pg8::gemm_phase<Epi, pg8::StaticOrder, true, true>((PG8_LAS unsigned char*)lds, g, S, e);
}

__device__ void phase_attn_naive(const Params& p, float* DIFF, int bid, int nb) {
    const bf16_t* DQ = (const bf16_t*)(p.ws + WS_DQ); const bf16_t* DK = (const bf16_t*)(p.ws + WS_DK); const bf16_t* DV = (const bf16_t*)(p.ws + WS_DV);
    const float lam = lambda_full(p);
    const int total = BATCH * NH * SEQ * 4;
    for (int w = bid * blockDim.x + threadIdx.x; w < total; w += nb * blockDim.x) {
        const int sl = w & 3, bh = (w >> 2) & 15, i = SEQ - 1 - (w >> 6), b = bh >> 2, h = bh & 3;
        const size_t rowq = (size_t)b * SEQ + i;
        float o0[32];
#pragma unroll
        for (int mp = 0; mp < 2; ++mp) {
            float q[64];
            { const u32x4* qp = (const u32x4*)(DQ + rowq * 512 + h * 128 + mp * 64);
#pragma unroll
              for (int c8 = 0; c8 < 8; ++c8) { const u32x4 u = qp[c8];
                  q[8 * c8 + 0] = bflo(u.x); q[8 * c8 + 1] = bfhi(u.x); q[8 * c8 + 2] = bflo(u.y); q[8 * c8 + 3] = bfhi(u.y);
                  q[8 * c8 + 4] = bflo(u.z); q[8 * c8 + 5] = bfhi(u.z); q[8 * c8 + 6] = bflo(u.w); q[8 * c8 + 7] = bfhi(u.w); } }
            float o[32];
#pragma unroll
            for (int e = 0; e < 32; ++e) o[e] = 0.f;
            float mx = -INFINITY, l = 0.f;
            for (int j = 0; j <= i; ++j) {
                const size_t rowk = (size_t)b * SEQ + j;
                const u32x4* kp = (const u32x4*)(DK + rowk * 512 + h * 128 + mp * 64);
                float s0 = 0.f, s1 = 0.f;
#pragma unroll
                for (int c8 = 0; c8 < 8; ++c8) { const u32x4 u = kp[c8];
                    s0 += q[8 * c8 + 0] * bflo(u.x); s1 += q[8 * c8 + 1] * bfhi(u.x); s0 += q[8 * c8 + 2] * bflo(u.y); s1 += q[8 * c8 + 3] * bfhi(u.y);
                    s0 += q[8 * c8 + 4] * bflo(u.z); s1 += q[8 * c8 + 5] * bfhi(u.z); s0 += q[8 * c8 + 6] * bflo(u.w); s1 += q[8 * c8 + 7] * bfhi(u.w); }
                const float s = s0 + s1;
                float pr;
                if (s > mx) { const float f = exp2f(mx - s); l = l * f + 1.f;
#pragma unroll
                    for (int e = 0; e < 32; ++e) o[e] *= f;
                    mx = s; pr = 1.f; }
                else { pr = exp2f(s - mx); l += pr; }
                const u32x4* vp = (const u32x4*)(DV + rowk * 512 + h * 128 + sl * 32);
#pragma unroll
                for (int c8 = 0; c8 < 4; ++c8) { const u32x4 u = vp[c8];
                    o[8 * c8 + 0] += pr * bflo(u.x); o[8 * c8 + 1] += pr * bfhi(u.x); o[8 * c8 + 2] += pr * bflo(u.y); o[8 * c8 + 3] += pr * bfhi(u.y);
                    o[8 * c8 + 4] += pr * bflo(u.z); o[8 * c8 + 5] += pr * bfhi(u.z); o[8 * c8 + 6] += pr * bflo(u.w); o[8 * c8 + 7] += pr * bfhi(u.w); }
            }
            const float il = 1.0f / l;
            if (mp == 0) {
#pragma unroll
                for (int e = 0; e < 32; ++e) o0[e] = o[e] * il;
            } else {
                float* dp = DIFF + rowq * 512 + h * 128 + sl * 32;
#pragma unroll
                for (int e = 0; e < 32; e += 4) *(f32x4*)(dp + e) = (f32x4){o0[e] - lam * o[e] * il, o0[e + 1] - lam * o[e + 1] * il, o0[e + 2] - lam * o[e + 2] * il, o0[e + 3] - lam * o[e + 3] * il};
            }
        }
    }
}

__device__ void phase_gla_naive(const Params& p, float* GO, int bid, int nb) {
    const bf16_t* GQ = (const bf16_t*)(p.ws + WS_GQ); const bf16_t* GK = (const bf16_t*)(p.ws + WS_GK); const bf16_t* GV = (const bf16_t*)(p.ws + WS_GV);
    const float* GLOG = (const float*)(p.ws + WS_GLOG);
    for (int w = bid * blockDim.x + threadIdx.x; w < BATCH * NH * 128; w += nb * blockDim.x) {
        const int dv = w & 127, bh = w >> 7, b = bh >> 2, h = bh & 3;
        float s[64];
#pragma unroll
        for (int d = 0; d < 64; ++d) s[d] = 0.f;
        for (int t = 0; t < SEQ; ++t) {
            const size_t row = (size_t)b * SEQ + t;
            const float v = bf2f(GV[row * 512 + h * 128 + dv]);
            const u32x4* qp = (const u32x4*)(GQ + row * 256 + h * 64); const u32x4* kp = (const u32x4*)(GK + row * 256 + h * 64);
            const f32x4* gp = (const f32x4*)(GLOG + row * 256 + h * 64);
            float o = 0.f;
#pragma unroll
            for (int c8 = 0; c8 < 8; ++c8) {
                const u32x4 qu = qp[c8], ku = kp[c8]; const f32x4 g0 = gp[2 * c8], g1 = gp[2 * c8 + 1];
                const float qf[8] = {bflo(qu.x), bfhi(qu.x), bflo(qu.y), bfhi(qu.y), bflo(qu.z), bfhi(qu.z), bflo(qu.w), bfhi(qu.w)};
                const float kf[8] = {bflo(ku.x), bfhi(ku.x), bflo(ku.y), bfhi(ku.y), bflo(ku.z), bfhi(ku.z), bflo(ku.w), bfhi(ku.w)};
                const float gf[8] = {g0[0], g0[1], g0[2], g0[3], g1[0], g1[1], g1[2], g1[3]};
#pragma unroll
                for (int e = 0; e < 8; ++e) { const int d = 8 * c8 + e; s[d] = __expf(gf[e]) * s[d] + kf[e] * v; o += qf[e] * s[d]; }
            }
            GO[row * 512 + h * 128 + dv] = o;
        }
    }
}

__device__ void phase_mixprep(const Params& p, const float* DIFF, const float* GO, int bid, int nb) {
    bf16_t* MIX = (bf16_t*)(p.ws + WS_MIX); const bf16_t* GR = (const bf16_t*)(p.ws + WS_GR);
    const int lane = threadIdx.x & 63, wpb = blockDim.x >> 6, gw = bid * wpb + (threadIdx.x >> 6), ngw = nb * wpb;
    for (int m = gw; m < M; m += ngw) {
        const bool gla = lane >= 32; const int cb = 16 * (lane & 31);
        if (!gla && !DIFF) continue;
        const float* src = (gla ? GO : DIFF) + (size_t)m * 512 + cb;
        float v[16]; float ss = 0.f;
#pragma unroll
        for (int e = 0; e < 16; e += 4) { const f32x4 t = *(const f32x4*)(src + e); v[e] = t[0]; v[e + 1] = t[1]; v[e + 2] = t[2]; v[e + 3] = t[3]; ss += (t[0] * t[0] + t[1] * t[1]) + (t[2] * t[2] + t[3] * t[3]); }
        ss += __shfl_xor(ss, 1); ss += __shfl_xor(ss, 2); ss += __shfl_xor(ss, 4);
        const float r = 1.0f / sqrtf(ss * (1.f / 128.f) + LN_EPS);
        const float* nw = (gla ? p.gla_norm_w : p.diff_norm_w) + (cb & 127);
        unsigned w[8];
#pragma unroll
        for (int e = 0; e < 16; e += 2) {
            float a = v[e] * r * nw[e], c = v[e + 1] * r * nw[e + 1];
            if (gla) { a *= bf2f(GR[(size_t)m * 512 + cb + e]); c *= bf2f(GR[(size_t)m * 512 + cb + e + 1]); }
            else { a *= (1.0f - LAMBDA_INIT); c *= (1.0f - LAMBDA_INIT); }
            w[e >> 1] = pk2(a, c);
        }
        u32x4* dst = (u32x4*)(MIX + (size_t)m * D + (gla ? 512 : 0) + cb);
        dst[0] = (u32x4){w[0], w[1], w[2], w[3]}; dst[1] = (u32x4){w[4], w[5], w[6], w[7]};
    }
}

__device__ void phase_convact(const Params& p, int half, int bid, int nb) {
    const bf16_t* UP = (const bf16_t*)(p.ws + WS_UPH); bf16_t* ACT = (bf16_t*)(p.ws + WS_ACTH);
    const int total = 8192 * (F / 4);
    for (int e = bid * blockDim.x + threadIdx.x; e < total; e += nb * blockDim.x) {
        const int t = e / (F / 4), j0 = (e % (F / 4)) * 4, s = (t + half * 8192) & (SEQ - 1);
        const int ca = 256 * (j0 >> 7) + (j0 & 127), cbb = ca + 128;
        float a[4], bq[4];
#pragma unroll
        for (int q = 0; q < 4; ++q) { a[q] = p.conv_b[j0 + q]; bq[q] = p.conv_b[F + j0 + q]; }
#pragma unroll
        for (int k = 0; k < 3; ++k) {
            const int dt = 2 - k;
            if (s - dt >= 0) {
                const u32x2 ua = *(const u32x2*)(UP + (size_t)(t - dt) * F2 + ca), ub = *(const u32x2*)(UP + (size_t)(t - dt) * F2 + cbb);
                const float xa[4] = {bflo(ua.x), bfhi(ua.x), bflo(ua.y), bfhi(ua.y)}, xb[4] = {bflo(ub.x), bfhi(ub.x), bflo(ub.y), bfhi(ub.y)};
#pragma unroll
                for (int q = 0; q < 4; ++q) { a[q] += p.conv_w[k * F2 + j0 + q] * xa[q]; bq[q] += p.conv_w[k * F2 + F + j0 + q] * xb[q]; }
            }
        }
        u32x2 w; w.x = pk2(silu_f(a[0]) * bq[0], silu_f(a[1]) * bq[1]); w.y = pk2(silu_f(a[2]) * bq[2], silu_f(a[3]) * bq[3]);
        *(u32x2*)(ACT + (size_t)t * F + j0) = w;
    }
}

namespace attn {
#define ATT_LAS __attribute__((address_space(3)))
typedef float f32x16 __attribute__((ext_vector_type(16)));
typedef short s16x4 __attribute__((ext_vector_type(4)));
typedef short v4i16_t __attribute__((ext_vector_type(4)));
constexpr int KVBUF = 32768, OFF_K0 = 0, OFF_K1 = 8192, OFF_V = 16384, OFF_XCH = 65536, OFF_WSF = 131072;
constexpr float THR = 6.0f, NEG = -1e30f;
__device__ __forceinline__ int crow(int r, int hi) { return (r & 3) + 8 * (r >> 2) + 4 * hi; }
__device__ __forceinline__ void glds16(const void* g, ATT_LAS unsigned char* dst) { __builtin_amdgcn_global_load_lds((const unsigned*)g, (ATT_LAS unsigned*)dst, 16, 0, 0); }
__device__ __forceinline__ s16x4 vtr(const ATT_LAS unsigned char* p) { return __builtin_bit_cast(s16x4, __builtin_amdgcn_ds_read_tr16_b64_v4i16((ATT_LAS v4i16_t*)p)); }
__device__ __forceinline__ float swap_max(float m) { auto rr = __builtin_amdgcn_permlane32_swap(__float_as_uint(m), __float_as_uint(m), false, false); return fmaxf(__uint_as_float(rr[0]), __uint_as_float(rr[1])); }
__device__ __forceinline__ float swap_sum(float m) { auto rr = __builtin_amdgcn_permlane32_swap(__float_as_uint(m), __float_as_uint(m), false, false); return __uint_as_float(rr[0]) + __uint_as_float(rr[1]); }

__device__ __forceinline__ void stage_tile(ATT_LAS unsigned char* buf, const bf16_t* Kg, const bf16_t* Vg, int t, int wid, int lane) {
    const size_t ro = (size_t)t * 64 * 512;
    glds16(Kg + ro + (size_t)lane * 512 + wid * 8, buf + OFF_K0 + wid * 1024);
    glds16(Kg + ro + (size_t)lane * 512 + 64 + wid * 8, buf + OFF_K1 + wid * 1024);
#pragma unroll
    for (int i = 0; i < 2; ++i) { const int pp = wid + 8 * i;
        glds16(Vg + ro + (size_t)(16 * (pp & 3) + (lane >> 2)) * 512 + (pp >> 2) * 32 + (lane & 3) * 8, buf + OFF_V + pp * 1024); }
}

template <bool MASK>
__device__ __forceinline__ void tile_step(const ATT_LAS unsigned char* buf, int mp, int lane, int r32, int hi, const bf16x8 (&qr)[4], f32x16 (&o)[4], float& mref, float& lsum,
                                          ATT_LAS float* wsf, int key0, int qabs) {
    const ATT_LAS unsigned char* kp = buf + (mp ? OFF_K1 : OFF_K0) + hi * 1024 + r32 * 16;
    f32x16 p0 = {}, p1 = {};
#pragma unroll
    for (int d0 = 0; d0 < 4; ++d0) {
        const bf16x8 a0 = *(const ATT_LAS bf16x8*)(kp + d0 * 2048), a1 = *(const ATT_LAS bf16x8*)(kp + d0 * 2048 + 512);
        p0 = __builtin_amdgcn_mfma_f32_32x32x16_bf16(a0, qr[d0], p0, 0, 0, 0);
        p1 = __builtin_amdgcn_mfma_f32_32x32x16_bf16(a1, qr[d0], p1, 0, 0, 0);
    }
    if (MASK) {
#pragma unroll
        for (int r = 0; r < 16; ++r) { const int key = key0 + crow(r, hi); if (key > qabs) p0[r] = NEG; if (key + 32 > qabs) p1[r] = NEG; }
    }
    float m = fmaxf(p0[0], p1[0]);
#pragma unroll
    for (int r = 1; r < 16; ++r) m = fmaxf(m, fmaxf(p0[r], p1[r]));
    const float rm = swap_max(m);
    if (__any(rm > mref + THR)) {
        const float mnew = fmaxf(mref, rm), f = __builtin_amdgcn_exp2f(mref - mnew);
        lsum *= f; mref = mnew;
        if (hi == 0) wsf[r32] = f;
#pragma unroll
        for (int g = 0; g < 4; ++g) { float f4[4];
#pragma unroll
            for (int i = 0; i < 4; ++i) f4[i] = wsf[8 * g + 4 * hi + i];
#pragma unroll
            for (int d0 = 0; d0 < 4; ++d0)
#pragma unroll
                for (int i = 0; i < 4; ++i) o[d0][4 * g + i] *= f4[i]; }
    }
    float s = 0.f;
#pragma unroll
    for (int r = 0; r < 16; ++r) { p0[r] = __builtin_amdgcn_exp2f(p0[r] - mref); p1[r] = __builtin_amdgcn_exp2f(p1[r] - mref); s += p0[r] + p1[r]; }
    lsum += s;
    bf16x8 pa[4];
    { u32x4 w;
      w.x = cvtpk(p0[0], p0[1]); w.y = cvtpk(p0[2], p0[3]); w.z = cvtpk(p0[4], p0[5]); w.w = cvtpk(p0[6], p0[7]); pa[0] = __builtin_bit_cast(bf16x8, w);
      w.x = cvtpk(p0[8], p0[9]); w.y = cvtpk(p0[10], p0[11]); w.z = cvtpk(p0[12], p0[13]); w.w = cvtpk(p0[14], p0[15]); pa[1] = __builtin_bit_cast(bf16x8, w);
      w.x = cvtpk(p1[0], p1[1]); w.y = cvtpk(p1[2], p1[3]); w.z = cvtpk(p1[4], p1[5]); w.w = cvtpk(p1[6], p1[7]); pa[2] = __builtin_bit_cast(bf16x8, w);
      w.x = cvtpk(p1[8], p1[9]); w.y = cvtpk(p1[10], p1[11]); w.z = cvtpk(p1[12], p1[13]); w.w = cvtpk(p1[14], p1[15]); pa[3] = __builtin_bit_cast(bf16x8, w); }
    const ATT_LAS unsigned char* vp = buf + OFF_V + ((lane >> 4) & 1) * 32 + (lane & 3) * 8 + (4 * hi + ((lane & 15) >> 2)) * 64;
#pragma unroll
    for (int d0 = 0; d0 < 4; ++d0) {
#pragma unroll
        for (int ks = 0; ks < 4; ++ks) {
            const s16x4 lo = vtr(vp + d0 * 4096 + ks * 1024), hh = vtr(vp + d0 * 4096 + ks * 1024 + 512);
            const bf16x8 vb = (bf16x8){lo[0], lo[1], lo[2], lo[3], hh[0], hh[1], hh[2], hh[3]};
            o[d0] = __builtin_amdgcn_mfma_f32_32x32x16_bf16(pa[ks], vb, o[d0], 0, 0, 0);
        }
    }
}

__device__ __forceinline__ void attn_unit(const Params& p, ATT_LAS unsigned char* lds, int b, int h, int qb, float lam) {
    int tid_ = threadIdx.x; asm volatile("" : "+v"(tid_));
    const int tid = tid_, lane = tid & 63, r32 = lane & 31, hi = lane >> 5, wid = __builtin_amdgcn_readfirstlane(tid >> 6), mp = wid >> 2, wq = wid & 3;
    const int q0 = qb * 128, NT = 2 * (qb + 1);
    const size_t rowbase = (size_t)b * SEQ;
    const bf16_t* Kg = (const bf16_t*)(p.ws + WS_DK) + rowbase * 512 + h * 128;
    const bf16_t* Vg = (const bf16_t*)(p.ws + WS_DV) + rowbase * 512 + h * 128;
    const bf16_t* Qw = (const bf16_t*)(p.ws + WS_DQ) + (rowbase + q0 + wq * 32 + r32) * 512 + h * 128 + mp * 64;
    ATT_LAS float* wsf = (ATT_LAS float*)(lds + OFF_WSF) + wid * 64;
    stage_tile(lds, Kg, Vg, 0, wid, lane);
    bf16x8 qr[4];
#pragma unroll
    for (int d0 = 0; d0 < 4; ++d0) qr[d0] = *(const bf16x8*)(Qw + d0 * 16 + hi * 8);
    f32x16 o[4];
#pragma unroll
    for (int d0 = 0; d0 < 4; ++d0) o[d0] = f32x16{};
    float mref = NEG, lsum = 0.f;
    const int qabs = q0 + wq * 32 + r32;
    for (int t = 0; t < NT; ++t) {
        asm volatile("s_waitcnt vmcnt(0)" ::: "memory");
        __syncthreads();
        if (t + 1 < NT) stage_tile(lds + ((t + 1) & 1) * KVBUF, Kg, Vg, t + 1, wid, lane);
        const ATT_LAS unsigned char* buf = lds + (t & 1) * KVBUF;
        if (t < NT - 2) tile_step<false>(buf, mp, lane, r32, hi, qr, o, mref, lsum, wsf, t * 64, qabs);
        else if (!(t == NT - 1 && wq < 2)) tile_step<true>(buf, mp, lane, r32, hi, qr, o, mref, lsum, wsf, t * 64, qabs);
    }
    const float linv = 1.0f / swap_sum(lsum);
    if (hi == 0) wsf[r32] = linv;
#pragma unroll
    for (int g = 0; g < 4; ++g) { float f4[4];
#pragma unroll
        for (int i = 0; i < 4; ++i) f4[i] = wsf[8 * g + 4 * hi + i];
#pragma unroll
        for (int d0 = 0; d0 < 4; ++d0)
#pragma unroll
            for (int i = 0; i < 4; ++i) o[d0][4 * g + i] *= f4[i]; }
    ATT_LAS float* xch = (ATT_LAS float*)(lds + OFF_XCH) + (size_t)wq * 4 * 16 * 64 + lane;
    if (mp == 1) {
#pragma unroll
        for (int d0 = 0; d0 < 4; ++d0)
#pragma unroll
            for (int r = 0; r < 16; ++r) xch[(d0 * 16 + r) * 64] = o[d0][r];
    }
    __syncthreads();
    if (mp == 0) {
        float nw[4];
#pragma unroll
        for (int d0 = 0; d0 < 4; ++d0) nw[d0] = p.diff_norm_w[32 * d0 + r32] * (1.0f - LAMBDA_INIT);
        bf16_t* Ow = (bf16_t*)(p.ws + WS_MIX) + (rowbase + q0 + wq * 32) * D + h * 128 + r32;
#pragma unroll
        for (int r = 0; r < 16; ++r) {
            float dsq = 0.f; float dv[4];
#pragma unroll
            for (int d0 = 0; d0 < 4; ++d0) { dv[d0] = o[d0][r] - lam * xch[(d0 * 16 + r) * 64]; dsq += dv[d0] * dv[d0]; }
            dsq += __shfl_xor(dsq, 1); dsq += __shfl_xor(dsq, 2); dsq += __shfl_xor(dsq, 4); dsq += __shfl_xor(dsq, 8); dsq += __shfl_xor(dsq, 16);
            const float rs = 1.0f / sqrtf(dsq * (1.0f / 128.0f) + LN_EPS);
            bf16_t* orow = Ow + (size_t)crow(r, hi) * D;
#pragma unroll
            for (int d0 = 0; d0 < 4; ++d0) orow[32 * d0] = (bf16_t)f2bf(dv[d0] * rs * nw[d0]);
        }
    }
    __syncthreads();
}

__device__ void phase_attn(const Params& p, unsigned char* lds_generic) {
    ATT_LAS unsigned char* lds = (ATT_LAS unsigned char*)lds_generic;
    const float lam = lambda_full(p);
    const int G = gridDim.x, bx = blockIdx.x, vcu = (G % 8 == 0) ? (bx % 8) * (G / 8) + bx / 8 : bx;
    for (int item = vcu; item < 256; item += G) {
        const int bh = item >> 4, s = item & 15;
        attn_unit(p, lds, bh >> 2, bh & 3, 31 - s, lam);
        attn_unit(p, lds, bh >> 2, bh & 3, s, lam);
    }
}
}

namespace gla {
#define GL_LAS __attribute__((address_space(3)))
typedef float f32x16 __attribute__((ext_vector_type(16)));
typedef short s16x4 __attribute__((ext_vector_type(4)));
typedef short v4i16_t __attribute__((ext_vector_type(4)));
constexpr size_t WS_DEC = WS_BIG + 176 * MiB;
__device__ __forceinline__ s16x4 vtr(const GL_LAS unsigned char* p) { return __builtin_bit_cast(s16x4, __builtin_amdgcn_ds_read_tr16_b64_v4i16((GL_LAS v4i16_t*)p)); }
__device__ __forceinline__ bf16x8 cat8(s16x4 lo, s16x4 hh) { return (bf16x8){lo[0], lo[1], lo[2], lo[3], hh[0], hh[1], hh[2], hh[3]}; }
__device__ __forceinline__ int crow(int r, int hi) { return (r & 3) + 8 * (r >> 2) + 4 * hi; }

__device__ __forceinline__ void stage_v(GL_LAS unsigned char* VI, const bf16_t* GVh  , int tid) {
    const int tok = tid >> 3, c8 = tid & 7;
    const u32x4* src = (const u32x4*)(GVh + (size_t)tok * 512 + c8 * 16);
    const u32x4 a = src[0], b = src[1];
    GL_LAS unsigned char* dst = VI + (c8 >> 1) * 4096 + tok * 64 + (c8 & 1) * 32;
    *(GL_LAS u32x4*)dst = a; *(GL_LAS u32x4*)(dst + 16) = b;
}

__device__ __forceinline__ void g1_unit(const Params& p, GL_LAS unsigned char* lds, int bh, int c) {
    int tid_ = threadIdx.x; asm volatile("" : "+v"(tid_));
    const int tid = tid_, lane = tid & 63, wid = __builtin_amdgcn_readfirstlane(tid >> 6), hi = lane >> 5, r32 = lane & 31;
    const int b = bh >> 2, h = bh & 3; const size_t row0 = (size_t)b * SEQ + c * 64;
    float* GLOG = (float*)(p.ws + WS_GLOG) + row0 * 256 + h * 64;
    const bf16_t* GK = (const bf16_t*)(p.ws + WS_GK) + row0 * 256 + h * 64;
    const bf16_t* GV = (const bf16_t*)(p.ws + WS_GV) + row0 * 512 + h * 128;
    float* DEC = (float*)(p.ws + WS_DEC) + (size_t)(bh * 64 + c) * 64;
    GL_LAS float* SEG = (GL_LAS float*)lds; GL_LAS unsigned char* KH = lds + 4096; GL_LAS unsigned char* VI = lds + 16384;
    const int d = tid & 63, seg = tid >> 6;
    float g[8], kv[8];
#pragma unroll
    for (int i = 0; i < 8; ++i) { g[i] = GLOG[(size_t)(seg * 8 + i) * 256 + d]; kv[i] = bf2f(GK[(size_t)(seg * 8 + i) * 256 + d]); }
    stage_v(VI, GV, tid);
#pragma unroll
    for (int i = 1; i < 8; ++i) g[i] += g[i - 1];
    SEG[seg * 64 + d] = g[7];
    __syncthreads();
    float pre = 0.f, tot = 0.f;
#pragma unroll
    for (int s = 0; s < 8; ++s) { const float v = SEG[s * 64 + d]; pre += (s < seg) ? v : 0.f; tot += v; }
#pragma unroll
    for (int i = 0; i < 8; ++i) { g[i] += pre; GLOG[(size_t)(seg * 8 + i) * 256 + d] = g[i];
        *(GL_LAS bf16_t*)(KH + (d >> 5) * 4096 + (seg * 8 + i) * 64 + (d & 31) * 2) = (bf16_t)f2bf(kv[i] * __expf(tot - g[i])); }
    if (seg == 0) DEC[d] = __expf(tot);
    __syncthreads();
    const int dblk = wid >> 2, dvb = wid & 3;
    const int toff = ((lane & 15) >> 2) * 64 + ((lane >> 4) & 1) * 32 + (lane & 3) * 8 + hi * 512;
    const GL_LAS unsigned char* ap = KH + dblk * 4096 + toff; const GL_LAS unsigned char* bp = VI + dvb * 4096 + toff;
    f32x16 acc = {};
#pragma unroll
    for (int ks = 0; ks < 4; ++ks) {
        const bf16x8 a = cat8(vtr(ap + ks * 1024), vtr(ap + ks * 1024 + 256)), bb = cat8(vtr(bp + ks * 1024), vtr(bp + ks * 1024 + 256));
        acc = __builtin_amdgcn_mfma_f32_32x32x16_bf16(a, bb, acc, 0, 0, 0);
    }
    float* U = (float*)(p.ws + WS_GLU) + (size_t)(bh * 64 + c) * 8192 + dvb * 32 + r32;
#pragma unroll
    for (int r = 0; r < 16; ++r) U[(size_t)(dblk * 32 + crow(r, hi)) * 128] = acc[r];
    __syncthreads();
}
__device__ void phase_g1(const Params& p, unsigned char* lds_generic) {
    GL_LAS unsigned char* lds = (GL_LAS unsigned char*)lds_generic;
    const int G = gridDim.x, bx = blockIdx.x, vcu = (G % 8 == 0) ? (bx % 8) * (G / 8) + bx / 8 : bx;
    for (int u = vcu; u < 1024; u += G) g1_unit(p, lds, u >> 6, u & 63);
}
__device__ void phase_g2(const Params& p, int bid, int nb) {
    float* GLU = (float*)(p.ws + WS_GLU); const float* DEC = (const float*)(p.ws + WS_DEC);
    for (int e = bid * blockDim.x + threadIdx.x; e < 16 * 8192; e += nb * blockDim.x) {
        const int bh = e >> 13, el = e & 8191, d = el >> 7;
        float* base = GLU + (size_t)bh * 64 * 8192 + el; const float* dec = DEC + (size_t)bh * 64 * 64 + d;
        float s = 0.f;
        for (int c0 = 0; c0 < 64; c0 += 16) {
            float u[16], dc[16];
#pragma unroll
            for (int i = 0; i < 16; ++i) { u[i] = base[(size_t)(c0 + i) * 8192]; dc[i] = dec[(c0 + i) * 64]; }
#pragma unroll
            for (int i = 0; i < 16; ++i) { base[(size_t)(c0 + i) * 8192] = s; s = dc[i] * s + u[i]; }
        }
    }
}
__device__ __forceinline__ void g3_unit(const Params& p, GL_LAS unsigned char* lds, int bh, int c) {
    int tid_ = threadIdx.x; asm volatile("" : "+v"(tid_));
    const int tid = tid_, lane = tid & 63, wid = __builtin_amdgcn_readfirstlane(tid >> 6), hi = lane >> 5, r32 = lane & 31;
    const int b = bh >> 2, h = bh & 3; const size_t row0 = (size_t)b * SEQ + c * 64;
    const float* GB = (const float*)(p.ws + WS_GLOG) + row0 * 256 + h * 64;
    const bf16_t* GQ = (const bf16_t*)(p.ws + WS_GQ) + row0 * 256 + h * 64; const bf16_t* GK = (const bf16_t*)(p.ws + WS_GK) + row0 * 256 + h * 64;
    const bf16_t* GV = (const bf16_t*)(p.ws + WS_GV) + row0 * 512 + h * 128; const bf16_t* GR = (const bf16_t*)(p.ws + WS_GR) + row0 * 512 + h * 128;
    const float* S = (const float*)(p.ws + WS_GLU) + (size_t)(bh * 64 + c) * 8192;
    GL_LAS unsigned char* QI = lds; GL_LAS unsigned char* KI = lds + 8192; GL_LAS unsigned char* VI = lds + 16384; GL_LAS unsigned char* SI = lds + 32768;
    GL_LAS float* OX = (GL_LAS float*)(lds + 49152);
    const int tok = tid >> 3, c8 = tid & 7;
    {
        const f32x4 b0 = *(const f32x4*)(GB + (size_t)tok * 256 + c8 * 8), b1 = *(const f32x4*)(GB + (size_t)tok * 256 + c8 * 8 + 4);
        const u32x4 qu = *(const u32x4*)(GQ + (size_t)tok * 256 + c8 * 8), ku = *(const u32x4*)(GK + (size_t)tok * 256 + c8 * 8);
        const float bv[8] = {b0[0], b0[1], b0[2], b0[3], b1[0], b1[1], b1[2], b1[3]};
        const float qf[8] = {bflo(qu.x), bfhi(qu.x), bflo(qu.y), bfhi(qu.y), bflo(qu.z), bfhi(qu.z), bflo(qu.w), bfhi(qu.w)};
        const float kf[8] = {bflo(ku.x), bfhi(ku.x), bflo(ku.y), bfhi(ku.y), bflo(ku.z), bfhi(ku.z), bflo(ku.w), bfhi(ku.w)};
        float qt[8], kt[8];
#pragma unroll
        for (int j = 0; j < 8; ++j) { qt[j] = qf[j] * __expf(bv[j]); kt[j] = kf[j] * __expf(-bv[j]); }
        *(GL_LAS u32x4*)(QI + c8 * 1024 + tok * 16) = (u32x4){cvtpk(qt[0], qt[1]), cvtpk(qt[2], qt[3]), cvtpk(qt[4], qt[5]), cvtpk(qt[6], qt[7])};
        *(GL_LAS u32x4*)(KI + c8 * 1024 + tok * 16) = (u32x4){cvtpk(kt[0], kt[1]), cvtpk(kt[2], kt[3]), cvtpk(kt[4], kt[5]), cvtpk(kt[6], kt[7])};
    }
    stage_v(VI, GV, tid);
    {
        const f32x4* sp = (const f32x4*)(S + (size_t)tok * 128 + c8 * 16);
        const f32x4 s0 = sp[0], s1 = sp[1], s2 = sp[2], s3 = sp[3];
        GL_LAS unsigned char* dst = SI + (c8 >> 1) * 4096 + tok * 64 + (c8 & 1) * 32;
        *(GL_LAS u32x4*)dst = (u32x4){cvtpk(s0[0], s0[1]), cvtpk(s0[2], s0[3]), cvtpk(s1[0], s1[1]), cvtpk(s1[2], s1[3])};
        *(GL_LAS u32x4*)(dst + 16) = (u32x4){cvtpk(s2[0], s2[1]), cvtpk(s2[2], s2[3]), cvtpk(s3[0], s3[1]), cvtpk(s3[2], s3[3])};
    }
    __syncthreads();
    const int ib = wid >> 2, dvb = wid & 3;
    bf16x8 qfr[4];
#pragma unroll
    for (int d0 = 0; d0 < 4; ++d0) qfr[d0] = *(const GL_LAS bf16x8*)(QI + (2 * d0 + hi) * 1024 + (32 * ib + r32) * 16);
    f32x16 o = {};
    const int tq = ((lane & 15) >> 2) * 64 + ((lane >> 4) & 1) * 32 + (lane & 3) * 8;
    const GL_LAS unsigned char* vp = VI + dvb * 4096 + tq + hi * 256;
    const GL_LAS unsigned char* sp2 = SI + dvb * 4096 + tq + hi * 512;
#pragma unroll
    for (int jb = 0; jb < 2; ++jb) {
        if (jb <= ib) {
            f32x16 pj = {};
#pragma unroll
            for (int d0 = 0; d0 < 4; ++d0) { const bf16x8 kf = *(const GL_LAS bf16x8*)(KI + (2 * d0 + hi) * 1024 + (32 * jb + r32) * 16);
                pj = __builtin_amdgcn_mfma_f32_32x32x16_bf16(kf, qfr[d0], pj, 0, 0, 0); }
            if (jb == ib) {
#pragma unroll
                for (int r = 0; r < 16; ++r) if (crow(r, hi) > r32) pj[r] = 0.f;
            }
            const bf16x8 pa0 = __builtin_bit_cast(bf16x8, (u32x4){cvtpk(pj[0], pj[1]), cvtpk(pj[2], pj[3]), cvtpk(pj[4], pj[5]), cvtpk(pj[6], pj[7])});
            const bf16x8 pa1 = __builtin_bit_cast(bf16x8, (u32x4){cvtpk(pj[8], pj[9]), cvtpk(pj[10], pj[11]), cvtpk(pj[12], pj[13]), cvtpk(pj[14], pj[15])});
            o = __builtin_amdgcn_mfma_f32_32x32x16_bf16(pa0, cat8(vtr(vp + (2 * jb) * 1024), vtr(vp + (2 * jb) * 1024 + 512)), o, 0, 0, 0);
            o = __builtin_amdgcn_mfma_f32_32x32x16_bf16(pa1, cat8(vtr(vp + (2 * jb + 1) * 1024), vtr(vp + (2 * jb + 1) * 1024 + 512)), o, 0, 0, 0);
        }
    }
#pragma unroll
    for (int d0 = 0; d0 < 4; ++d0) o = __builtin_amdgcn_mfma_f32_32x32x16_bf16(qfr[d0], cat8(vtr(sp2 + d0 * 1024), vtr(sp2 + d0 * 1024 + 256)), o, 0, 0, 0);
#pragma unroll
    for (int r = 0; r < 16; ++r) OX[(32 * ib + crow(r, hi)) * 132 + dvb * 32 + r32] = o[r];
    __syncthreads();
    {
        float v[16]; float ss = 0.f;
#pragma unroll
        for (int e = 0; e < 16; ++e) { v[e] = OX[tok * 132 + c8 * 16 + e]; ss += v[e] * v[e]; }
        ss += __shfl_xor(ss, 1); ss += __shfl_xor(ss, 2); ss += __shfl_xor(ss, 4);
        const float rs = 1.0f / sqrtf(ss * (1.0f / 128.0f) + LN_EPS);
        const u32x4 g0 = *(const u32x4*)(GR + (size_t)tok * 512 + c8 * 16), g1 = *(const u32x4*)(GR + (size_t)tok * 512 + c8 * 16 + 8);
        const float gr[16] = {bflo(g0.x), bfhi(g0.x), bflo(g0.y), bfhi(g0.y), bflo(g0.z), bfhi(g0.z), bflo(g0.w), bfhi(g0.w),
                              bflo(g1.x), bfhi(g1.x), bflo(g1.y), bfhi(g1.y), bflo(g1.z), bfhi(g1.z), bflo(g1.w), bfhi(g1.w)};
        const float* nw = p.gla_norm_w + c8 * 16; unsigned w[8];
#pragma unroll
        for (int e = 0; e < 16; e += 2) w[e >> 1] = cvtpk(v[e] * rs * nw[e] * gr[e], v[e + 1] * rs * nw[e + 1] * gr[e + 1]);
        u32x4* dst = (u32x4*)((bf16_t*)(p.ws + WS_MIX) + (row0 + tok) * D + 512 + h * 128 + c8 * 16);
        dst[0] = (u32x4){w[0], w[1], w[2], w[3]}; dst[1] = (u32x4){w[4], w[5], w[6], w[7]};
    }
    __syncthreads();
}
__device__ void phase_g3(const Params& p, unsigned char* lds_generic) {
    GL_LAS unsigned char* lds = (GL_LAS unsigned char*)lds_generic;
    const int G = gridDim.x, bx = blockIdx.x, vcu = (G % 8 == 0) ? (bx % 8) * (G / 8) + bx / 8 : bx;
    for (int u = vcu; u < 1024; u += G) g3_unit(p, lds, u >> 6, u & 63);
}
}

#define LAS __attribute__((address_space(3)))
#define XB_TMO      128
#define XB_XCNT(j)  (256  + 64 * (j))
#define XB_XSUB(j)  (1280 + 64 * (j))
#define XB_XGEN(j)  (2304 + 64 * (j))
#define XB_TOP      3328
#define XB_TOPGEN   3392
#define XCD_BAR_WORDS 3456
#define XB_SPIN_CAP (1u << 18)

__device__ __forceinline__ unsigned xb_ld(unsigned* p)              { return __hip_atomic_load(p, __ATOMIC_RELAXED, __HIP_MEMORY_SCOPE_AGENT); }
__device__ __forceinline__ unsigned xb_add(unsigned* p, unsigned v) { return __hip_atomic_fetch_add(p, v, __ATOMIC_RELAXED, __HIP_MEMORY_SCOPE_AGENT); }
__device__ __forceinline__ unsigned xb_xcc_id() { return (unsigned)__builtin_amdgcn_s_getreg((3 << 11) | 20) & 0xFu; }
#define XB_SPIN(cond, bar) do { unsigned _sp = 0; while (cond) { __builtin_amdgcn_s_sleep(1); \
    if ((++_sp & 255u) == 0u) { if (xb_ld(&(bar)[XB_TMO])) break; if (_sp > XB_SPIN_CAP) { atomicAdd(&(bar)[XB_TMO], 1u); break; } } } } while (0)

struct XcdBarrier {
    unsigned* bar; unsigned x;
    volatile LAS unsigned* st;
};

__device__ __forceinline__ XcdBarrier xcd_barrier_post(unsigned* bar, volatile LAS unsigned* st) {
    XcdBarrier b; b.bar = bar; b.x = xb_xcc_id(); b.st = st;
    if (threadIdx.x == 0) (void)xb_add(&bar[XB_XCNT(b.x)], 1u);
    return b;
}
__device__ __forceinline__ void xcd_barrier_complete(unsigned* bar, unsigned x, unsigned& nloc, unsigned& nx) {
    const unsigned G = gridDim.x * gridDim.y * gridDim.z;
    unsigned sum, cnt, mine, sp = 0u;
    for (;;) {
        sum = 0u; cnt = 0u; mine = 0u;
#pragma unroll
        for (unsigned j = 0; j < 16; ++j) { const unsigned c = xb_ld(&bar[XB_XCNT(j)]); sum += c; cnt += (c > 0u) ? 1u : 0u; mine = (j == x) ? c : mine; }
        if (sum == G) break;
        __builtin_amdgcn_s_sleep(1);
        if ((++sp & 255u) == 0u) { if (xb_ld(&bar[XB_TMO])) break; if (sp > XB_SPIN_CAP) { atomicAdd(&bar[XB_TMO], 1u); break; } }
    }
    nloc = mine > 0u ? mine : 1u; nx = cnt > 0u ? cnt : 1u;
}

__device__ __forceinline__ void xcd_barrier(const XcdBarrier& b) {
    asm volatile("s_waitcnt vmcnt(0)" ::: "memory");
    __syncthreads();
    if (threadIdx.x == 0) {
        unsigned* bar = b.bar;
        __builtin_amdgcn_s_waitcnt(0);
        unsigned nloc = b.st[0], nx = b.st[1];
        if (nloc == 0u) { xcd_barrier_complete(bar, b.x, nloc, nx); b.st[0] = nloc; b.st[1] = nx; }
        const unsigned old = xb_add(&bar[XB_XSUB(b.x)], 1u);
        const unsigned gen = old / nloc;
        if (old + 1u == (gen + 1u) * nloc) {
            __builtin_amdgcn_fence(__ATOMIC_RELEASE, "agent");
            asm volatile("s_waitcnt vmcnt(0)" ::: "memory");
            const unsigned og = xb_add(&bar[XB_TOP], 1u);
            const unsigned tg = og / nx;
            if (og + 1u == (tg + 1u) * nx) xb_add(&bar[XB_TOPGEN], 1u);
            else XB_SPIN(xb_ld(&bar[XB_TOPGEN]) == tg, bar);
            __builtin_amdgcn_fence(__ATOMIC_ACQUIRE, "agent");
            xb_add(&bar[XB_XGEN(b.x)], 1u);
            asm volatile("s_waitcnt vmcnt(0)" ::: "memory");
        } else {
            XB_SPIN(xb_ld(&bar[XB_XGEN(b.x)]) == gen, bar);
            __builtin_amdgcn_fence(__ATOMIC_ACQUIRE, "agent");
            asm volatile("s_waitcnt vmcnt(0)" ::: "memory");
        }
    }
    __syncthreads();
}

template <int PH> __device__ __forceinline__ void run_phase(const Params& p, float* smem, int bid, int nb) {
    if constexpr (PH == 0) { phase_ada(p, smem, bid, nb); phase_wprep(p, smem, bid, nb); phase_rope(p, bid, nb); }
    else if constexpr (PH == 1) phase_ln_in(p, bid, nb);
    else if constexpr (PH == 2) { EpiInP e{p.ws, p.b_gate}; gemm_pg8((unsigned char*)smem, (const bf16_t*)(p.ws + WS_XN), (const bf16_t*)(p.ws + WS_WIN), M, N_INX, D, e); }
    else if constexpr (PH == 3) gla::phase_g1(p, (unsigned char*)smem);
    else if constexpr (PH == 4) gla::phase_g2(p, bid, nb);
    else if constexpr (PH == 5) { attn::phase_attn(p, (unsigned char*)smem); gla::phase_g3(p, (unsigned char*)smem); }
    else if constexpr (PH == 6) { EpiOutP e{&p}; gemm_pg8((unsigned char*)smem, (const bf16_t*)(p.ws + WS_MIX), (const bf16_t*)(p.ws + WS_WOUT), M, D, D, e); }
    else if constexpr (PH == 7) phase_ln_rows(p, p.out, p.ln_attn_g, p.ln_attn_b, (bf16_t*)(p.ws + WS_XN), 3072, 4096, bid, nb);
    else if constexpr (PH == 8) {
        EpiUpConv e{&p, (bf16_t*)(p.ws + WS_ACT), (PG8_LAS float*)((PG8_LAS unsigned char*)(unsigned char*)smem + XL_OFF)};
        pg8::Gemm g{(const bf16_t*)(p.ws + WS_XN) - 2 * D, (const bf16_t*)(p.ws + WS_WUP), 65 * 256, F2, D, 254}; pg8::StaticOrder S; S.init(65 * 256, F2, (int)gridDim.x, (int)blockIdx.x);
        pg8::gemm_phase<EpiUpConv, pg8::StaticOrder, true, true>((PG8_LAS unsigned char*)(unsigned char*)smem, g, S, e); }
    else if constexpr (PH == 9) { EpiDownP e{&p, 0}; gemm_pg8((unsigned char*)smem, (const bf16_t*)(p.ws + WS_ACT), (const bf16_t*)(p.ws + WS_WDOWN), M, D, F, e); }
    else if constexpr (PH == 10) phase_ln_rows(p, p.out, p.ln_ffn_g, p.ln_ffn_b, nullptr, 0, 0, bid, nb);
}
constexpr int LAST_PHASE = 10;

constexpr int NTHREADS = 512;
constexpr int LDS_BYTES = 147456;

template <int PH> __global__ void __launch_bounds__(NTHREADS, 2) k_phase(Params p) {
    extern __shared__ __attribute__((aligned(16))) unsigned char lds[];
    run_phase<PH>(p, (float*)lds, blockIdx.x, gridDim.x);
}
constexpr int MISC_OFF = 135168;
constexpr int CW_BAR = 4096;
constexpr size_t CTL_ZERO_BYTES = 65536;
template <int PH> struct PhaseLoop { static __device__ __forceinline__ void run(const Params& p, float* smem, const XcdBarrier& bar) {
    run_phase<PH>(p, smem, blockIdx.x, gridDim.x);
    if constexpr (PH < LAST_PHASE) { xcd_barrier(bar); PhaseLoop<PH + 1>::run(p, smem, bar); } } };
__global__ void __launch_bounds__(NTHREADS, 2) k_mega(Params p) {
    extern __shared__ __attribute__((aligned(16))) unsigned char lds[];
    volatile LAS unsigned* misc = (volatile LAS unsigned*)((LAS unsigned char*)lds + MISC_OFF);
    if (threadIdx.x < 32) misc[threadIdx.x] = 0u;
    __syncthreads();
    const XcdBarrier bar = xcd_barrier_post((unsigned*)(p.ws + WS_CTL) + CW_BAR, misc + 8);
    PhaseLoop<0>::run(p, (float*)lds, bar);
}

template <int PH> static void launch_phases(const Params& p, int grid, hipStream_t stream) {
    static bool attr_set = false;
    if (!attr_set) { (void)hipFuncSetAttribute((const void*)k_phase<PH>, hipFuncAttributeMaxDynamicSharedMemorySize, LDS_BYTES); attr_set = true; }
    hipLaunchKernelGGL(k_phase<PH>, dim3(grid), dim3(NTHREADS), LDS_BYTES, stream, p);
    if constexpr (PH < LAST_PHASE) launch_phases<PH + 1>(p, grid, stream);
}

extern "C" void kernel_launch(void* const* d_in, const int* in_sizes, int n_in, void* d_out, int out_size, void* d_ws, size_t ws_size, hipStream_t stream) {
    if (n_in != 25 || in_sizes[0] != M * D || out_size != M * D || ws_size < WS_END) {
        fprintf(stderr, "kernel_launch: unexpected shapes (n_in %d, in0 %d, out %d, ws %zu)\n", n_in, n_in > 0 ? in_sizes[0] : -1, out_size, ws_size); return; }
    Params p{};
    p.x = (const float*)d_in[0]; p.c = (const float*)d_in[1]; p.pos = (const int*)d_in[2]; p.ln_in_g = (const float*)d_in[3]; p.ln_in_b = (const float*)d_in[4];
    p.w_ada = (const float*)d_in[5]; p.b_ada = (const float*)d_in[6]; p.w_in = (const float*)d_in[7];
    p.lq1 = (const float*)d_in[8]; p.lk1 = (const float*)d_in[9]; p.lq2 = (const float*)d_in[10]; p.lk2 = (const float*)d_in[11];
    p.diff_norm_w = (const float*)d_in[12]; p.w_gate_up = (const float*)d_in[13]; p.b_gate = (const float*)d_in[14]; p.gla_norm_w = (const float*)d_in[15];
    p.w_out = (const float*)d_in[16]; p.ln_attn_g = (const float*)d_in[17]; p.ln_attn_b = (const float*)d_in[18];
    p.w_up = (const float*)d_in[19]; p.conv_w = (const float*)d_in[20]; p.conv_b = (const float*)d_in[21]; p.w_down = (const float*)d_in[22];
    p.ln_ffn_g = (const float*)d_in[23]; p.ln_ffn_b = (const float*)d_in[24];
    p.out = (float*)d_out; p.ws = (unsigned char*)d_ws;
#if ONE_LAUNCH
    static int grid_blocks = 0;
    if (!grid_blocks) {
        int dev = 0, cus = 0, per_cu = 0;
        (void)hipGetDevice(&dev); (void)hipDeviceGetAttribute(&cus, hipDeviceAttributeMultiprocessorCount, dev);
        (void)hipFuncSetAttribute((const void*)k_mega, hipFuncAttributeMaxDynamicSharedMemorySize, LDS_BYTES);
        (void)hipOccupancyMaxActiveBlocksPerMultiprocessor(&per_cu, (const void*)k_mega, NTHREADS, LDS_BYTES);
        if (per_cu != 1) fprintf(stderr, "note: occupancy query says %d workgroups per CU (expected 1)\n", per_cu);
        grid_blocks = cus;
    }
    (void)hipMemsetAsync((unsigned char*)d_ws + WS_CTL, 0, CTL_ZERO_BYTES, stream);
    void* args[] = {&p};
    hipError_t e = hipLaunchCooperativeKernel((const void*)k_mega, dim3(grid_blocks), dim3(NTHREADS), args, LDS_BYTES, stream);
    if (e != hipSuccess) fprintf(stderr, "cooperative launch failed: %s (grid %d)\n", hipGetErrorString(e), grid_blocks);
#else
    launch_phases<0>(p, 256, stream);
#endif
}
```

```cpp
#include <hip/hip_runtime.h>
#include <stdint.h>
#include <stdio.h>

#ifndef ONE_LAUNCH
#define ONE_LAUNCH 1
#endif

typedef unsigned short bf16_t;
typedef short bf16x8 __attribute__((ext_vector_type(8)));
typedef float f32x4 __attribute__((ext_vector_type(4)));
typedef unsigned u32x4 __attribute__((ext_vector_type(4)));
typedef unsigned u32x2 __attribute__((ext_vector_type(2)));

constexpr int D = 1024, BATCH = 4, SEQ = 4096, M = BATCH * SEQ;
constexpr int NH = 4;
constexpr int N_INX = 3328;
constexpr int F = 2816, F2 = 5632;
constexpr float LN_EPS = 1e-5f;
constexpr float DN_ALPHA = 1.189207115002721f;
constexpr float LAMBDA_INIT = 0.2f;
constexpr float QSCALE = 0.125f * 1.4426950408889634f;

constexpr size_t MiB = 1u << 20;
constexpr size_t WS_CTL = 0;
constexpr size_t WS_ADA = 1 * MiB;
constexpr size_t WS_STATS2 = 1 * MiB + 512 * 1024;
constexpr size_t WS_STATS = 1 * MiB + 256 * 1024;
constexpr size_t WS_COS = 2 * MiB, WS_SIN = 4 * MiB;
constexpr size_t WS_WIN = 6 * MiB;
constexpr size_t WS_WOUT = 13 * MiB;
constexpr size_t WS_WUP = 15 * MiB;
constexpr size_t WS_WDOWN = 26 * MiB;
constexpr size_t WS_XN = 32 * MiB + 4096;
constexpr size_t WS_BIG = 65 * MiB;
constexpr size_t WS_DQ = WS_BIG, WS_DK = WS_BIG + 16 * MiB, WS_DV = WS_BIG + 32 * MiB;
constexpr size_t WS_GQ = WS_BIG + 48 * MiB, WS_GK = WS_BIG + 56 * MiB;
constexpr size_t WS_GV = WS_BIG + 64 * MiB, WS_GR = WS_BIG + 80 * MiB;
constexpr size_t WS_GLOG = WS_BIG + 96 * MiB;
constexpr size_t WS_MIX = WS_BIG + 112 * MiB;
constexpr size_t WS_GLU = WS_BIG + 144 * MiB;
constexpr size_t WS_ACT = WS_BIG;
constexpr int XL_OFF = 136192;
constexpr size_t WS_UPH = WS_BIG;
constexpr size_t WS_ACTH = WS_BIG + 88 * MiB;
constexpr size_t WS_END = 256 * MiB;

struct Params {
    const float* x; const float* c; const int* pos; const float* ln_in_g; const float* ln_in_b;
    const float* w_ada; const float* b_ada; const float* w_in;
    const float* lq1; const float* lk1; const float* lq2; const float* lk2;
    const float* diff_norm_w; const float* w_gate_up; const float* b_gate; const float* gla_norm_w;
    const float* w_out; const float* ln_attn_g; const float* ln_attn_b;
    const float* w_up; const float* conv_w; const float* conv_b; const float* w_down;
    const float* ln_ffn_g; const float* ln_ffn_b;
    float* out; unsigned char* ws;
};

__device__ __forceinline__ unsigned f2bf(float f) { unsigned u = __builtin_bit_cast(unsigned, f); return (u + 0x7fffu + ((u >> 16) & 1u)) >> 16; }
__device__ __forceinline__ unsigned pk2(float lo, float hi) { return f2bf(lo) | (f2bf(hi) << 16); }
typedef float f32x2_t __attribute__((ext_vector_type(2)));
typedef __bf16 bf16x2_t __attribute__((ext_vector_type(2)));
__device__ __forceinline__ unsigned cvtpk(float lo, float hi) { f32x2_t v = {lo, hi}; bf16x2_t b = __builtin_convertvector(v, bf16x2_t); return __builtin_bit_cast(unsigned, b); }
__device__ __forceinline__ float bf2f(unsigned short b) { return __builtin_bit_cast(float, (unsigned)b << 16); }
__device__ __forceinline__ float bflo(unsigned w) { return __builtin_bit_cast(float, w << 16); }
__device__ __forceinline__ float bfhi(unsigned w) { return __builtin_bit_cast(float, w & 0xffff0000u); }
__device__ __forceinline__ float wave_sum(float v) {
#pragma unroll
    for (int o = 1; o < 64; o <<= 1) v += __shfl_xor(v, o);
    return v;
}
__device__ __forceinline__ float silu_f(float v) { return v / (1.0f + __expf(-v)); }
__device__ __forceinline__ float lambda_full(const Params& p) {
    float s1 = 0.f, s2 = 0.f;
    for (int i = 0; i < 64; ++i) { s1 += p.lq1[i] * p.lk1[i]; s2 += p.lq2[i] * p.lk2[i]; }
    return expf(s1) - expf(s2) + LAMBDA_INIT;
}

__device__ void phase_ada(const Params& p, float* smem, int bid, int nb) {
    float* ada = (float*)(p.ws + WS_ADA);
    constexpr int NKL = 64, NIT = D / NKL;
    const int t = threadIdx.x, cgp = t & 7, kl = t >> 3;
    float ca[4][NIT];
    if (bid < 6144 / 32) {
#pragma unroll
        for (int b = 0; b < 4; ++b)
#pragma unroll
            for (int i = 0; i < NIT; ++i) ca[b][i] = silu_f(p.c[b * D + kl + NKL * i]);
    }
    for (int item = bid; item < 6144 / 32; item += nb) {
        const int n0 = item * 32;
        f32x4 w[NIT];
#pragma unroll
        for (int i = 0; i < NIT; ++i) w[i] = *(const f32x4*)(p.w_ada + (size_t)(kl + NKL * i) * 6144 + n0 + 4 * cgp);
        float acc[4][4];
#pragma unroll
        for (int b = 0; b < 4; ++b)
#pragma unroll
            for (int j = 0; j < 4; ++j) { float s = 0.f;
#pragma unroll
                for (int i = 0; i < NIT; ++i) s += ca[b][i] * w[i][j];
                acc[b][j] = s; }
        __syncthreads();
#pragma unroll
        for (int b = 0; b < 4; ++b)
#pragma unroll
            for (int j = 0; j < 4; ++j) smem[(kl * 32 + 4 * cgp + j) * 4 + b] = acc[b][j];
        __syncthreads();
        if (t < 128) { const int col = t & 31, b = t >> 5; float s = 0.f;
#pragma unroll 8
            for (int q = 0; q < NKL; ++q) s += smem[(q * 32 + col) * 4 + b];
            ada[b * 6144 + n0 + col] = s + p.b_ada[n0 + col]; }
    }
}

__device__ __forceinline__ void wprep_item(const Params& p, float* scr, int kind, int tn, int tk, int lane) {
    const float* W; int N, K; bf16_t* WT;
    if (kind == 0) { W = p.w_in; N = 3088; K = D; WT = (bf16_t*)(p.ws + WS_WIN); }
    else if (kind == 1) { W = p.w_out; N = D; K = D; WT = (bf16_t*)(p.ws + WS_WOUT); }
    else if (kind == 2) { W = p.w_up; N = F2; K = D; WT = (bf16_t*)(p.ws + WS_WUP); }
    else { W = p.w_down; N = D; K = F; WT = (bf16_t*)(p.ws + WS_WDOWN); }
    const int n0 = tn * 32, k0 = tk * 64, nl = lane & 31, kh = lane >> 5, np = n0 + nl;
    if (kind == 0 && n0 >= 3072) {
        const int j = np - 3072; float g[16];
#pragma unroll
        for (int r = 0; r < 16; ++r) g[r] = p.w_gate_up[r * 256 + j];
#pragma unroll 4
        for (int i = 0; i < 32; ++i) { const int kk = 2 * i + kh; const f32x4* wr = (const f32x4*)(W + (size_t)(k0 + kk) * N + 3072); float s = 0.f;
#pragma unroll
            for (int r4 = 0; r4 < 4; ++r4) { const f32x4 w = wr[r4]; s += w[0] * g[4 * r4] + w[1] * g[4 * r4 + 1] + w[2] * g[4 * r4 + 2] + w[3] * g[4 * r4 + 3]; }
            scr[kk * 33 + nl] = s; }
    } else {
        int src;
        if (kind == 0) { if (np < 1024) { const int pp = np & 63; src = (np & ~63) + (pp >> 1) + 32 * (pp & 1); } else src = np; }
        else if (kind == 2) { const int pn = np >> 8, w = np & 255; src = (w < 128) ? (128 * pn + w) : (F + 128 * pn + (w - 128)); }
        else src = np;
        const float* wp = W + (size_t)(k0 + kh) * N + src;
        float wv[32];
#pragma unroll
        for (int i = 0; i < 32; ++i) wv[i] = wp[(size_t)(2 * i) * N];
#pragma unroll
        for (int i = 0; i < 32; ++i) scr[(2 * i + kh) * 33 + nl] = wv[i];
    }
    asm volatile("s_waitcnt lgkmcnt(0)" ::: "memory");
    const int c = lane & 7;
#pragma unroll
    for (int j = 0; j < 4; ++j) { const int n = (lane >> 3) + 8 * j; const float* s = scr + (8 * c) * 33 + n;
        u32x4 o; o.x = cvtpk(s[0 * 33], s[1 * 33]); o.y = cvtpk(s[2 * 33], s[3 * 33]); o.z = cvtpk(s[4 * 33], s[5 * 33]); o.w = cvtpk(s[6 * 33], s[7 * 33]);
        *(u32x4*)(WT + (size_t)(n0 + n) * K + k0 + 8 * c) = o; }
    asm volatile("s_waitcnt lgkmcnt(0)" ::: "memory");
}
__device__ void phase_wprep(const Params& p, float* smem, int bid, int nb) {
    constexpr int T0 = (N_INX / 32) * (D / 64), T1 = (D / 32) * (D / 64), T2 = (F2 / 32) * (D / 64), T3 = (D / 32) * (F / 64);
    const int lane = threadIdx.x & 63, wv = threadIdx.x >> 6, wpb = blockDim.x >> 6;
    float* scr = smem + wv * (64 * 33);
    for (int it = bid * wpb + wv; it < T0 + T1 + T2 + T3; it += nb * wpb) {
        int r = it;
        if (r < T0) { wprep_item(p, scr, 0, r / (D / 64), r % (D / 64), lane); continue; } r -= T0;
        if (r < T1) { wprep_item(p, scr, 1, r / (D / 64), r % (D / 64), lane); continue; } r -= T1;
        if (r < T2) { wprep_item(p, scr, 2, r / (D / 64), r % (D / 64), lane); continue; } r -= T2;
        wprep_item(p, scr, 3, r / (F / 64), r % (F / 64), lane);
    }
    __syncthreads();
}

__device__ void phase_rope(const Params& p, int bid, int nb) {
    float* COS = (float*)(p.ws + WS_COS); float* SIN = (float*)(p.ws + WS_SIN);
    for (int e = bid * blockDim.x + threadIdx.x; e < M * 32; e += nb * blockDim.x) {
        const int m = e >> 5, i = e & 31;
        double inv = 1.0; const double r = 0.74989420933245582730;
        for (int q = 0; q < i; ++q) inv *= r;
        const float invf = (float)inv;
        const double a = (double)((float)p.pos[m] * invf);
        const double qd = __builtin_rint(a * 0.63661977236758134308);
        const double rr = __builtin_fma(-qd, 1.57079632679489661923, a);
        const float x = (float)rr, x2 = x * x;
        const float s = x * (1.f + x2 * (-1.f / 6.f + x2 * (1.f / 120.f + x2 * (-1.f / 5040.f + x2 * (1.f / 362880.f)))));
        const float cc = 1.f + x2 * (-0.5f + x2 * (1.f / 24.f + x2 * (-1.f / 720.f + x2 * (1.f / 40320.f + x2 * (-1.f / 3628800.f)))));
        const int qi = (int)((long long)qd & 3);
        float co, si;
        if (qi == 0) { co = cc; si = s; } else if (qi == 1) { co = -s; si = cc; } else if (qi == 2) { co = -cc; si = -s; } else { co = s; si = -cc; }
        COS[e] = co; SIN[e] = si;
    }
}

__device__ __forceinline__ void ln_stats(const f32x4 (&v)[4], float& mean, float& rstd) {
    float s = 0.f;
#pragma unroll
    for (int j = 0; j < 4; ++j) s += (v[j].x + v[j].y) + (v[j].z + v[j].w);
    mean = wave_sum(s) * (1.f / D); float s2 = 0.f;
#pragma unroll
    for (int j = 0; j < 4; ++j) { const f32x4 d = v[j] - mean; s2 += (d.x * d.x + d.y * d.y) + (d.z * d.z + d.w * d.w); }
    rstd = 1.0f / sqrtf(wave_sum(s2) * (1.f / D) + LN_EPS);
}
constexpr int LNR = 2;
__device__ __forceinline__ void ln_load(f32x4 (&v)[LNR][4], const float* R, int m0, int lane) {
#pragma unroll
    for (int r = 0; r < LNR; ++r)
#pragma unroll
        for (int j = 0; j < 4; ++j) v[r][j] = ((const f32x4*)(R + (size_t)(m0 + r) * D) + lane)[64 * j];
}
__device__ void phase_ln_in(const Params& p, int bid, int nb) {
    const float* ada = (const float*)(p.ws + WS_ADA); float* stats = (float*)(p.ws + WS_STATS); bf16_t* XN = (bf16_t*)(p.ws + WS_XN);
    const int lane = threadIdx.x & 63, wpb = blockDim.x >> 6, gw = bid * wpb + (threadIdx.x >> 6), ngw = nb * wpb;
    f32x4 v[LNR][4], vn[LNR][4];
    int m0 = LNR * gw;
    if (m0 < M) ln_load(vn, p.x, m0, lane);
    for (; m0 < M; m0 += LNR * ngw) {
#pragma unroll
        for (int r = 0; r < LNR; ++r)
#pragma unroll
            for (int j = 0; j < 4; ++j) v[r][j] = vn[r][j];
        if (m0 + LNR * ngw < M) ln_load(vn, p.x, m0 + LNR * ngw, lane);
        const int b = m0 / SEQ;
#pragma unroll
        for (int r = 0; r < LNR; ++r) {
            const int m = m0 + r;
            float mean, rstd; ln_stats(v[r], mean, rstd);
            if (lane == 0) { stats[2 * m] = mean; stats[2 * m + 1] = rstd; }
            u32x2* o8 = (u32x2*)(XN + (size_t)m * D) + lane;
#pragma unroll
            for (int j = 0; j < 4; ++j) {
                const int col = 4 * lane + 256 * j;
                const f32x4 g = *(const f32x4*)(p.ln_in_g + col), bb = *(const f32x4*)(p.ln_in_b + col);
                const f32x4 sh = *(const f32x4*)(ada + b * 6144 + col), sc = *(const f32x4*)(ada + b * 6144 + 1024 + col);
                const f32x4 h = (v[r][j] - mean) * rstd * g + bb;
                const f32x4 u = h * (1.0f + sc) + sh;
                u32x2 w; w.x = cvtpk(u.x, u.y); w.y = cvtpk(u.z, u.w); o8[64 * j] = w;
            }
        }
    }
}
template <bool WRITE_H>
__device__ void phase_ln_rows(const Params& p, float* R, const float* g, const float* bb, bf16_t* XN2, float* stats2, int sh_off, int sc_off, int bid, int nb) {
    const float* ada = (const float*)(p.ws + WS_ADA);
    const int lane = threadIdx.x & 63, wpb = blockDim.x >> 6, gw = bid * wpb + (threadIdx.x >> 6), ngw = nb * wpb;
    f32x4 v[LNR][4], vn[LNR][4];
    int m0 = LNR * gw;
    if (m0 < M) ln_load(vn, R, m0, lane);
    for (; m0 < M; m0 += LNR * ngw) {
#pragma unroll
        for (int r = 0; r < LNR; ++r)
#pragma unroll
            for (int j = 0; j < 4; ++j) v[r][j] = vn[r][j];
        if (m0 + LNR * ngw < M) ln_load(vn, R, m0 + LNR * ngw, lane);
        const int b = m0 / SEQ;
#pragma unroll
        for (int r = 0; r < LNR; ++r) {
            const int m = m0 + r;
            float mean, rstd; ln_stats(v[r], mean, rstd);
            if (stats2 && lane == 0) { stats2[2 * m] = mean; stats2[2 * m + 1] = rstd; }
#pragma unroll
            for (int j = 0; j < 4; ++j) {
                const int col = 4 * lane + 256 * j;
                const f32x4 gg = *(const f32x4*)(g + col), b4 = *(const f32x4*)(bb + col);
                const f32x4 h = (v[r][j] - mean) * rstd * gg + b4;
                if (WRITE_H) ((f32x4*)(R + (size_t)m * D) + lane)[64 * j] = h;
                if (XN2) {
                    const f32x4 sh = *(const f32x4*)(ada + b * 6144 + sh_off + col), sc = *(const f32x4*)(ada + b * 6144 + sc_off + col);
                    const f32x4 u = h * (1.0f + sc) + sh;
                    u32x2 w; w.x = cvtpk(u.x, u.y); w.y = cvtpk(u.z, u.w); ((u32x2*)(XN2 + (size_t)m * D) + lane)[64 * j] = w;
                }
            }
        }
    }
}

template <class Epi>
__device__ void gemm_simple(const bf16_t* A, int lda, const bf16_t* Bt, int ldb, int Mrows, int N, int K, const Epi& epi, int bid, int nb) {
    const int lane = threadIdx.x & 63, fr = lane & 15, fq = lane >> 4, wpb = blockDim.x >> 6, gw = bid * wpb + (threadIdx.x >> 6), ngw = nb * wpb;
    const int ntn = N / 32, ntiles = (Mrows / 32) * ntn;
    for (int tile = gw; tile < ntiles; tile += ngw) {
        const int m0 = (tile / ntn) * 32, n0 = (tile % ntn) * 32;
        f32x4 acc[2][2];
#pragma unroll
        for (int i = 0; i < 2; ++i)
#pragma unroll
            for (int j = 0; j < 2; ++j) acc[i][j] = (f32x4){0.f, 0.f, 0.f, 0.f};
        const bf16_t* ap = A + (size_t)(m0 + fr) * lda + 8 * fq;
        const bf16_t* bp = Bt + (size_t)(n0 + fr) * ldb + 8 * fq;
#pragma unroll 4
        for (int k0 = 0; k0 < K; k0 += 32) {
            bf16x8 a[2], b[2];
            a[0] = *(const bf16x8*)(ap + k0); a[1] = *(const bf16x8*)(ap + (size_t)16 * lda + k0);
            b[0] = *(const bf16x8*)(bp + k0); b[1] = *(const bf16x8*)(bp + (size_t)16 * ldb + k0);
#pragma unroll
            for (int i = 0; i < 2; ++i)
#pragma unroll
                for (int j = 0; j < 2; ++j) acc[i][j] = __builtin_amdgcn_mfma_f32_16x16x32_bf16(b[j], a[i], acc[i][j], 0, 0, 0);
        }
#pragma unroll
        for (int i = 0; i < 2; ++i)
#pragma unroll
            for (int j = 0; j < 2; ++j) epi(m0 + 16 * i + fr, n0 + 16 * j + 4 * fq, acc[i][j]);
    }
}

struct EpiIn {
    unsigned char* ws; const float* b_gate;
    __device__ __forceinline__ void operator()(int row, int col0, f32x4 v) const {
        if (col0 < 1024) {
            const int i0 = (col0 & 63) >> 1;
            const float* COS = (const float*)(ws + WS_COS) + (size_t)row * 32 + i0; const float* SIN = (const float*)(ws + WS_SIN) + (size_t)row * 32 + i0;
            const float c0 = COS[0], c1 = COS[1], s0 = SIN[0], s1 = SIN[1];
            float o0 = v[0] * c0 - v[1] * s0, o1 = v[1] * c0 + v[0] * s0, o2 = v[2] * c1 - v[3] * s1, o3 = v[3] * c1 + v[2] * s1;
            bf16_t* dst;
            if (col0 < 512) { o0 *= QSCALE; o1 *= QSCALE; o2 *= QSCALE; o3 *= QSCALE; dst = (bf16_t*)(ws + WS_DQ) + (size_t)row * 512 + col0; }
            else dst = (bf16_t*)(ws + WS_DK) + (size_t)row * 512 + (col0 - 512);
            u32x2 w; w.x = pk2(o0, o1); w.y = pk2(o2, o3); *(u32x2*)dst = w;
        } else if (col0 < 3072) {
            bf16_t* dst;
            if (col0 < 1536) dst = (bf16_t*)(ws + WS_DV) + (size_t)row * 512 + (col0 - 1024);
            else if (col0 < 1792) { v = v * 0.125f; dst = (bf16_t*)(ws + WS_GQ) + (size_t)row * 256 + (col0 - 1536); }
            else if (col0 < 2048) dst = (bf16_t*)(ws + WS_GK) + (size_t)row * 256 + (col0 - 1792);
            else if (col0 < 2560) dst = (bf16_t*)(ws + WS_GV) + (size_t)row * 512 + (col0 - 2048);
            else { v = (f32x4){silu_f(v[0]), silu_f(v[1]), silu_f(v[2]), silu_f(v[3])}; dst = (bf16_t*)(ws + WS_GR) + (size_t)row * 512 + (col0 - 2560); }
            u32x2 w; w.x = pk2(v[0], v[1]); w.y = pk2(v[2], v[3]); *(u32x2*)dst = w;
        } else {
            const int j = col0 - 3072; f32x4 o;
#pragma unroll
            for (int q = 0; q < 4; ++q) { const float z = v[q] + b_gate[j + q]; o[q] = (fminf(z, 0.f) - __logf(1.0f + __expf(-fabsf(z)))) * (1.0f / 16.0f); }
            *(f32x4*)((float*)(ws + WS_GLOG) + (size_t)row * 256 + j) = o;
        }
    }
};
struct EpiOut {
    const Params* p;
    __device__ __forceinline__ void operator()(int row, int col0, f32x4 v) const {
        const float* ada = (const float*)(p->ws + WS_ADA); const float* stats = (const float*)(p->ws + WS_STATS);
        const int b = row / SEQ; const float mean = stats[2 * row], rstd = stats[2 * row + 1];
        const f32x4 xv = *(const f32x4*)(p->x + (size_t)row * D + col0), g = *(const f32x4*)(p->ln_in_g + col0), bb = *(const f32x4*)(p->ln_in_b + col0);
        const f32x4 gt = *(const f32x4*)(ada + b * 6144 + 2048 + col0);
        const f32x4 h0 = (xv - mean) * rstd * g + bb;
        *(f32x4*)(p->out + (size_t)row * D + col0) = h0 * DN_ALPHA + (1.0f + gt) * v;
    }
};
struct EpiUpRaw {
    bf16_t* UP; int row_off;
    __device__ __forceinline__ void operator()(int row, int col0, f32x4 v) const {
        u32x2 w; w.x = pk2(v[0], v[1]); w.y = pk2(v[2], v[3]); *(u32x2*)(UP + (size_t)row * F2 + col0) = w;
    }
};
struct EpiDown {
    const Params* p; int row_off;
    __device__ __forceinline__ void operator()(int row, int col0, f32x4 v) const {
        const float* ada = (const float*)(p->ws + WS_ADA);
        const int grow = row + row_off, b = grow / SEQ;
        const f32x4 gt = *(const f32x4*)(ada + b * 6144 + 5120 + col0);
        f32x4* o = (f32x4*)(p->out + (size_t)grow * D + col0);
        *o = (*o) * DN_ALPHA + (1.0f + gt) * v;
    }
};


namespace pg8 {
#define PG8_LAS __attribute__((address_space(3)))
typedef unsigned short bf16_t;
typedef short bf16x8 __attribute__((ext_vector_type(8)));
typedef float f32x4 __attribute__((ext_vector_type(4)));
typedef unsigned u32x4 __attribute__((ext_vector_type(4)));
constexpr int BM = 256, BK = 64, HALF = 128, HTB = HALF * BK * 2  , STAGE_BYTES = 8 * HTB, NXCD = 8, WGM = 8;

__host__ __device__ __forceinline__ int lds_byte(int r, int c) { const int st = (r >> 4) * 2 + (c >> 5), rr = r & 15, cc = c & 31, ob = rr * 64 + cc * 2; return st * 1024 + (ob ^ (((ob >> 9) & 1) << 5)); }
__host__ __device__ __forceinline__ void stage_rc(int b, int& R, int& C) { const int st = b / 1024, sb = b % 1024, swz = sb ^ (((sb >> 9) & 1) << 5); R = (st >> 1) * 16 + swz / 64; C = (st & 1) * 32 + (swz % 64) / 2; }
__host__ __device__ __forceinline__ int perm32(int rho) { const int n = rho >> 4, i = rho & 15; return 8 * (i >> 2) + 4 * n + (i & 3); }

struct Unit { int pm, pn; };
struct Gemm { const bf16_t* A; const bf16_t* Bt; int M, N, K; int a_rows; };

struct StaticOrder {
    int nM, nN, nwg, G, c;
    __host__ __device__ void init(int M, int N, int G_, int c_) { nM = M / BM; nN = N / BM; nwg = nM * nN; G = G_; c = c_; }
    __host__ __device__ bool next(int i, Unit& u) const {
        const long L = (long)i * G + c; if (L >= nwg) return false;
        int wgid = (int)L; { const int q = nwg / NXCD, r = nwg % NXCD, xcd = wgid % NXCD, off = wgid / NXCD; wgid = (xcd < r ? xcd * (q + 1) : r * (q + 1) + (xcd - r) * q) + off; }
        const int nig = WGM * nN, gid = wgid / nig, fm = gid * WGM, gsz = (nM - fm) < WGM ? (nM - fm) : WGM;
        u.pm = fm + ((wgid % nig) % gsz); u.pn = (wgid % nig) / gsz; return true;
    }
    __device__ __forceinline__ void a_ready(const Unit&) const {}
    __device__ __forceinline__ void done(const Unit&) const {}
};
__device__ __forceinline__ unsigned cvt_pk_bf16(float lo, float hi) { unsigned r; asm volatile("v_cvt_pk_bf16_f32 %0, %1, %2" : "=v"(r) : "v"(lo), "v"(hi)); return r; }
template <class Epi, class Sched, bool ALIGN_EPI = false, bool SP2 = false>
__device__ __forceinline__ void gemm_phase(PG8_LAS unsigned char* lds, const Gemm g, const Sched& S, const Epi& E) {
    int tid_ = threadIdx.x; asm volatile("" : "+v"(tid_));
    const int tid = tid_, wid = __builtin_amdgcn_readfirstlane(tid >> 6), lane = tid & 63, wr = wid >> 2, wc = wid & 3, fr = lane & 15, fq = lane >> 4;
    const int K = g.K, nt = K / BK;
    unsigned voffA[2], voffA1[2], voffB[2];
#pragma unroll
    for (int i = 0; i < 2; ++i) { int R, C; stage_rc(tid * 16 + i * 8192, R, C); const int Rb = Epi::PERM ? ((R & ~31) + perm32(R & 31)) : R;
        if constexpr (Epi::APERM) {
            const int Ra = 128 * (R >> 6) + 8 * (R & 15) + ((R >> 4) & 3); voffA[i] = (unsigned)(Ra * K + C) * 2u; voffA1[i] = (unsigned)((Ra + 4) * K + C) * 2u; }
        else { voffA[i] = (unsigned)(R * K + C) * 2u; voffA1[i] = (unsigned)((R + HALF) * K + C) * 2u; }
        voffB[i] = (unsigned)(Rb * K + C) * 2u; }
    const size_t kstep = (size_t)(BK * 2);
    const size_t hstep = (size_t)HALF * K * 2;
    const size_t tstep = 2 * hstep;
    const size_t tstepA = (size_t)g.a_rows * K * 2;
    const unsigned ldsw = (unsigned)wid * 1024u;
    const int aoff = lds_byte(wr * 64 + fr, fq * 8), boff = lds_byte(wc * 32 + fr, fq * 8);
#define PG8_SA(b, h) (((b) * 2 + (h)) * HTB)
#define PG8_SB(b, h) ((4 + (b) * 2 + (h)) * HTB)
#define PG8_STAGE(bufoff, gbase, voff) do { _Pragma("unroll") for (int _i = 0; _i < 2; ++_i) \
        __builtin_amdgcn_global_load_lds((const unsigned*)((const char*)(gbase) + (voff)[_i]), (PG8_LAS unsigned*)(lds + (bufoff) + ldsw + _i * 8192), 16, 0, 0); } while (0)
#define PG8_LDA(dst, b, h) do { _Pragma("unroll") for (int m = 0; m < 4; ++m) _Pragma("unroll") for (int k = 0; k < 2; ++k) dst[m][k] = *(const PG8_LAS bf16x8*)(lds + PG8_SA(b, h) + aoff + m * 2048 + k * 1024); } while (0)
#define PG8_LDB(dst, b, h) do { _Pragma("unroll") for (int n = 0; n < 2; ++n) _Pragma("unroll") for (int k = 0; k < 2; ++k) dst[n][k] = *(const PG8_LAS bf16x8*)(lds + PG8_SB(b, h) + boff + n * 2048 + k * 1024); } while (0)
#define PG8_MMA(ai, bj, At, Bt) do { __builtin_amdgcn_s_setprio(1); _Pragma("unroll") for (int m = 0; m < 4; ++m) _Pragma("unroll") for (int n = 0; n < 2; ++n) _Pragma("unroll") for (int k = 0; k < 2; ++k) \
        acc[ai][bj][m][n] = __builtin_amdgcn_mfma_f32_16x16x32_bf16(Bt[n][k], At[m][k], acc[ai][bj][m][n], 0, 0, 0); __builtin_amdgcn_s_setprio(0); } while (0)
#define PG8_WAIT_V(n) asm volatile("s_waitcnt vmcnt(" #n ")" ::: "memory")
#define PG8_WAIT_L(n) asm volatile("s_waitcnt lgkmcnt(" #n ")" ::: "memory")
#define PG8_BAR __builtin_amdgcn_s_barrier()
#define PG8_SCHED __builtin_amdgcn_sched_barrier(0)
    Unit cur, nxt; int ui = 0;
    if (!S.next(0, cur)) return;
    f32x4 acc[2][2][4][2];
#pragma unroll
    for (int a = 0; a < 2; ++a)
#pragma unroll
        for (int b = 0; b < 2; ++b)
#pragma unroll
            for (int m = 0; m < 4; ++m)
#pragma unroll
                for (int n = 0; n < 2; ++n) acc[a][b][m][n] = (f32x4){0.f, 0.f, 0.f, 0.f};
    bf16x8 At[4][2], B0[2][2], B1[2][2];
    const char* cA = (const char*)g.A + (size_t)cur.pm * tstepA; const char* cB = (const char*)g.Bt + (size_t)cur.pn * tstep;
    S.a_ready(cur);
    if constexpr (SP2) {
        PG8_STAGE(PG8_SB(0, 0), cB, voffB); PG8_STAGE(PG8_SB(0, 1), cB + hstep, voffB); PG8_STAGE(PG8_SA(0, 0), cA, voffA); PG8_STAGE(PG8_SA(0, 1), cA, voffA1);
        if (wr == 1) PG8_BAR;
        PG8_WAIT_V(2); PG8_BAR;
        PG8_STAGE(PG8_SB(1, 0), cB + kstep, voffB); PG8_STAGE(PG8_SA(1, 0), cA + kstep, voffA); PG8_STAGE(PG8_SB(1, 1), cB + hstep + kstep, voffB);
        PG8_WAIT_V(6); PG8_BAR;
    } else {
        PG8_STAGE(PG8_SB(0, 0), cB, voffB); PG8_STAGE(PG8_SA(0, 0), cA, voffA); PG8_STAGE(PG8_SB(0, 1), cB + hstep, voffB); PG8_STAGE(PG8_SA(0, 1), cA, voffA1);
        if (wr == 1) PG8_BAR;
        PG8_WAIT_V(4); PG8_BAR;
        PG8_STAGE(PG8_SB(1, 0), cB + kstep, voffB); PG8_STAGE(PG8_SA(1, 0), cA + kstep, voffA); PG8_STAGE(PG8_SB(1, 1), cB + hstep + kstep, voffB);
        PG8_WAIT_V(6); PG8_BAR;
    }
    for (;;) {
        const bool has_next = S.next(ui + 1, nxt);
        const char* nA = has_next ? (const char*)g.A + (size_t)nxt.pm * tstepA : cA; const char* nB = has_next ? (const char*)g.Bt + (size_t)nxt.pn * tstep : cB;
        for (int t = 0; t < nt; t += 2) {
            const bool last = (t == nt - 2);
            const char* a1 = cA + (size_t)(t + 1) * kstep;
            const char* a2 = last ? nA : cA + (size_t)(t + 2) * kstep; const char* b2 = last ? nB : cB + (size_t)(t + 2) * kstep;
            const char* a3 = a2 + kstep; const char* b3 = b2 + kstep;
            if (last && has_next) S.a_ready(nxt);
            if constexpr (SP2) {
            PG8_LDB(B0, 0, 0); PG8_LDB(B1, 0, 1); PG8_SCHED; PG8_LDA(At, 0, 0); PG8_STAGE(PG8_SA(1, 1), a1, voffA1);
            PG8_WAIT_V(8); PG8_WAIT_L(0); PG8_BAR; PG8_MMA(0, 0, At, B0); PG8_MMA(0, 1, At, B1); PG8_BAR; PG8_SCHED;
            PG8_LDA(At, 0, 1); PG8_STAGE(PG8_SB(0, 0), b2, voffB); PG8_STAGE(PG8_SB(0, 1), b2 + hstep, voffB); PG8_STAGE(PG8_SA(0, 0), a2, voffA);
            PG8_WAIT_V(8); PG8_WAIT_L(0); PG8_BAR; PG8_MMA(1, 0, At, B0); PG8_MMA(1, 1, At, B1); PG8_BAR; PG8_SCHED;
            PG8_LDB(B0, 1, 0); PG8_LDB(B1, 1, 1); PG8_SCHED; PG8_LDA(At, 1, 0); PG8_STAGE(PG8_SA(0, 1), a2, voffA1);
            PG8_WAIT_V(8); PG8_WAIT_L(0); PG8_BAR; PG8_MMA(0, 0, At, B0); PG8_MMA(0, 1, At, B1); PG8_BAR; PG8_SCHED;
            PG8_LDA(At, 1, 1); PG8_STAGE(PG8_SB(1, 0), b3, voffB); PG8_STAGE(PG8_SB(1, 1), b3 + hstep, voffB); PG8_STAGE(PG8_SA(1, 0), a3, voffA);
            PG8_WAIT_V(8); PG8_WAIT_L(0); PG8_BAR; PG8_MMA(1, 0, At, B0); PG8_MMA(1, 1, At, B1); PG8_BAR; PG8_SCHED;
            } else {
            PG8_LDB(B0, 0, 0); PG8_SCHED; PG8_LDA(At, 0, 0); PG8_STAGE(PG8_SA(1, 1), a1, voffA1);
            PG8_WAIT_L(8); PG8_BAR; PG8_WAIT_L(0); PG8_MMA(0, 0, At, B0); PG8_BAR; PG8_SCHED;
            PG8_LDB(B1, 0, 1); PG8_STAGE(PG8_SB(0, 0), b2, voffB);
            PG8_BAR; PG8_WAIT_L(0); PG8_MMA(0, 1, At, B1); PG8_BAR;
            PG8_LDA(At, 0, 1); PG8_STAGE(PG8_SA(0, 0), a2, voffA);
            PG8_BAR; PG8_WAIT_L(0); PG8_MMA(1, 0, At, B0); PG8_BAR; PG8_SCHED;
            PG8_STAGE(PG8_SB(0, 1), b2 + hstep, voffB);
            PG8_WAIT_V(6); PG8_BAR; PG8_MMA(1, 1, At, B1); PG8_BAR;
            PG8_LDB(B0, 1, 0); PG8_SCHED; PG8_LDA(At, 1, 0); PG8_STAGE(PG8_SA(0, 1), a2, voffA1);
            PG8_WAIT_L(8); PG8_BAR; PG8_WAIT_L(0); PG8_MMA(0, 0, At, B0); PG8_BAR; PG8_SCHED;
            PG8_LDB(B1, 1, 1); PG8_STAGE(PG8_SB(1, 0), b3, voffB);
            PG8_BAR; PG8_WAIT_L(0); PG8_MMA(0, 1, At, B1); PG8_BAR;
            PG8_LDA(At, 1, 1); PG8_STAGE(PG8_SA(1, 0), a3, voffA);
            PG8_BAR; PG8_WAIT_L(0); PG8_MMA(1, 0, At, B0); PG8_BAR; PG8_SCHED;
            PG8_STAGE(PG8_SB(1, 1), b3 + hstep, voffB);
            PG8_WAIT_V(6); PG8_BAR; PG8_MMA(1, 1, At, B1); PG8_BAR;
            }
        }
        if constexpr (ALIGN_EPI) { if (wr == 0) PG8_BAR; }
        if constexpr (!Epi::AFTER_DRAIN) { E(acc, cur, wr, wc, fr, fq); S.done(cur); }
        if (!has_next) break;
#pragma unroll
        for (int a = 0; a < 2; ++a)
#pragma unroll
            for (int b = 0; b < 2; ++b)
#pragma unroll
                for (int m = 0; m < 4; ++m)
#pragma unroll
                    for (int n = 0; n < 2; ++n) acc[a][b][m][n] = (f32x4){0.f, 0.f, 0.f, 0.f};
        cur = nxt; cA = nA; cB = nB; ++ui;
        if constexpr (ALIGN_EPI) { if (wr == 1) PG8_BAR; }
    }
    PG8_WAIT_V(0);
    if constexpr (!ALIGN_EPI) { if (wr == 0) PG8_BAR; }
    PG8_BAR;
    if constexpr (Epi::AFTER_DRAIN) { E.fused(acc, cur, wr, wc, fr, fq, lds, wid, lane); S.done(cur); }
#undef PG8_SA
#undef PG8_SB
#undef PG8_STAGE
#undef PG8_LDA
#undef PG8_LDB
#undef PG8_MMA
#undef PG8_WAIT_V
#undef PG8_WAIT_L
#undef PG8_BAR
#undef PG8_SCHED
}
}

struct EpiInP {
    static constexpr bool PERM = true, AFTER_DRAIN = false, APERM = false;
    unsigned char* ws; const float* b_gate;
    __device__ __forceinline__ void operator()(const f32x4 (&acc)[2][2][4][2], const pg8::Unit& u, int wr, int wc, int fr, int fq) const {
        const int pn = u.pn, cw = wc * 32 + 8 * fq, rowb = u.pm * 256 + wr * 64 + fr;
        if (pn < 4) {
            const int i0 = (cw & 63) >> 1;
            bf16_t* base = (bf16_t*)(ws + (pn < 2 ? WS_DQ : WS_DK)) + (pn & 1) * 256 + cw;
            const float sc = pn < 2 ? QSCALE : 1.0f;
            const float* COS = (const float*)(ws + WS_COS) + i0; const float* SIN = (const float*)(ws + WS_SIN) + i0;
#pragma unroll
            for (int ai = 0; ai < 2; ++ai)
#pragma unroll
                for (int m = 0; m < 4; ++m) { const int row = rowb + ai * 128 + m * 16;
                    const f32x4 c = *(const f32x4*)(COS + (size_t)row * 32), s = *(const f32x4*)(SIN + (size_t)row * 32);
#pragma unroll
                    for (int bj = 0; bj < 2; ++bj) { const f32x4 v0 = acc[ai][bj][m][0], v1 = acc[ai][bj][m][1]; u32x4 w;
                        w.x = cvtpk((v0[0] * c[0] - v0[1] * s[0]) * sc, (v0[1] * c[0] + v0[0] * s[0]) * sc);
                        w.y = cvtpk((v0[2] * c[1] - v0[3] * s[1]) * sc, (v0[3] * c[1] + v0[2] * s[1]) * sc);
                        w.z = cvtpk((v1[0] * c[2] - v1[1] * s[2]) * sc, (v1[1] * c[2] + v1[0] * s[2]) * sc);
                        w.w = cvtpk((v1[2] * c[3] - v1[3] * s[3]) * sc, (v1[3] * c[3] + v1[2] * s[3]) * sc);
                        *(u32x4*)(base + (size_t)row * 512 + bj * 128) = w; } }
        } else if (pn < 12) {
            bf16_t* base; int pitch; float mul = 1.0f; bool act = false;
            if (pn < 6) { base = (bf16_t*)(ws + WS_DV) + (pn - 4) * 256; pitch = 512; }
            else if (pn == 6) { base = (bf16_t*)(ws + WS_GQ); pitch = 256; mul = 0.125f; }
            else if (pn == 7) { base = (bf16_t*)(ws + WS_GK); pitch = 256; }
            else if (pn < 10) { base = (bf16_t*)(ws + WS_GV) + (pn - 8) * 256; pitch = 512; }
            else { base = (bf16_t*)(ws + WS_GR) + (pn - 10) * 256; pitch = 512; act = true; }
            base += cw;
#pragma unroll
            for (int ai = 0; ai < 2; ++ai)
#pragma unroll
                for (int m = 0; m < 4; ++m) { const int row = rowb + ai * 128 + m * 16;
#pragma unroll
                    for (int bj = 0; bj < 2; ++bj) { f32x4 v0 = acc[ai][bj][m][0] * mul, v1 = acc[ai][bj][m][1] * mul;
                        if (act) { v0 = (f32x4){silu_f(v0[0]), silu_f(v0[1]), silu_f(v0[2]), silu_f(v0[3])}; v1 = (f32x4){silu_f(v1[0]), silu_f(v1[1]), silu_f(v1[2]), silu_f(v1[3])}; }
                        u32x4 w; w.x = cvtpk(v0[0], v0[1]); w.y = cvtpk(v0[2], v0[3]); w.z = cvtpk(v1[0], v1[1]); w.w = cvtpk(v1[2], v1[3]);
                        *(u32x4*)(base + (size_t)row * pitch + bj * 128) = w; } }
        } else {
            float* base = (float*)(ws + WS_GLOG) + cw;
#pragma unroll
            for (int bj = 0; bj < 2; ++bj) { const f32x4 b0 = *(const f32x4*)(b_gate + bj * 128 + cw), b1 = *(const f32x4*)(b_gate + bj * 128 + cw + 4);
#pragma unroll
                for (int ai = 0; ai < 2; ++ai)
#pragma unroll
                    for (int m = 0; m < 4; ++m) { const int row = rowb + ai * 128 + m * 16; const f32x4 z0 = acc[ai][bj][m][0] + b0, z1 = acc[ai][bj][m][1] + b1; f32x4 o0, o1;
#pragma unroll
                        for (int q = 0; q < 4; ++q) { o0[q] = (fminf(z0[q], 0.f) - __logf(1.0f + __expf(-fabsf(z0[q])))) * (1.0f / 16.0f); o1[q] = (fminf(z1[q], 0.f) - __logf(1.0f + __expf(-fabsf(z1[q])))) * (1.0f / 16.0f); }
                        float* d = base + (size_t)row * 256 + bj * 128; *(f32x4*)d = o0; *(f32x4*)(d + 4) = o1; } }
        }
    }
};
struct EpiOutP {
    static constexpr bool PERM = false, AFTER_DRAIN = false, APERM = false;
    const Params* p;
    __device__ __forceinline__ void operator()(const f32x4 (&acc)[2][2][4][2], const pg8::Unit& u, int wr, int wc, int fr, int fq) const {
        const float* ada = (const float*)(p->ws + WS_ADA); const float* stats = (const float*)(p->ws + WS_STATS);
        const int rowb = u.pm * 256 + wr * 64 + fr, col0 = u.pn * 256 + wc * 32 + 4 * fq, b = (u.pm * 256) / SEQ;
        float mean[2][4], rstd[2][4];
#pragma unroll
        for (int ai = 0; ai < 2; ++ai)
#pragma unroll
            for (int m = 0; m < 4; ++m) { const int row = rowb + ai * 128 + m * 16; mean[ai][m] = stats[2 * row]; rstd[ai][m] = stats[2 * row + 1]; }
#pragma unroll
        for (int bj = 0; bj < 2; ++bj)
#pragma unroll
            for (int n = 0; n < 2; ++n) { const int col = col0 + bj * 128 + n * 16;
                const f32x4 g = *(const f32x4*)(p->ln_in_g + col), bb = *(const f32x4*)(p->ln_in_b + col), gt = 1.0f + *(const f32x4*)(ada + b * 6144 + 2048 + col);
#pragma unroll
                for (int ai = 0; ai < 2; ++ai)
#pragma unroll
                    for (int m = 0; m < 4; ++m) { const size_t off = (size_t)(rowb + ai * 128 + m * 16) * D + col;
                        const f32x4 xv = *(const f32x4*)(p->x + off); const f32x4 h0 = (xv - mean[ai][m]) * rstd[ai][m] * g + bb;
                        *(f32x4*)(p->out + off) = h0 * DN_ALPHA + gt * acc[ai][bj][m][n]; } }
    }
};
struct EpiUpRawP {
    static constexpr bool PERM = true, AFTER_DRAIN = false, APERM = false;
    bf16_t* UP;
    __device__ __forceinline__ void operator()(const f32x4 (&acc)[2][2][4][2], const pg8::Unit& u, int wr, int wc, int fr, int fq) const {
        const int rowb = u.pm * 256 + wr * 64 + fr; bf16_t* base = UP + u.pn * 256 + wc * 32 + 8 * fq;
#pragma unroll
        for (int ai = 0; ai < 2; ++ai)
#pragma unroll
            for (int m = 0; m < 4; ++m)
#pragma unroll
                for (int bj = 0; bj < 2; ++bj) { const f32x4 v0 = acc[ai][bj][m][0], v1 = acc[ai][bj][m][1];
                    u32x4 w; w.x = cvtpk(v0[0], v0[1]); w.y = cvtpk(v0[2], v0[3]); w.z = cvtpk(v1[0], v1[1]); w.w = cvtpk(v1[2], v1[3]);
                    *(u32x4*)(base + (size_t)(rowb + ai * 128 + m * 16) * F2 + bj * 128) = w; }
    }
};
struct EpiDownP {
    static constexpr bool PERM = false, AFTER_DRAIN = false, APERM = false;
    const Params* p; int row_off;
    __device__ __forceinline__ void operator()(const f32x4 (&acc)[2][2][4][2], const pg8::Unit& u, int wr, int wc, int fr, int fq) const {
        const float* ada = (const float*)(p->ws + WS_ADA); const float* stats = (const float*)(p->ws + WS_STATS2);
        const int rowb = row_off + u.pm * 256 + wr * 64 + fr, col0 = u.pn * 256 + wc * 32 + 4 * fq, b = (row_off + u.pm * 256) / SEQ;
        float mean[2][4], rstd[2][4];
#pragma unroll
        for (int ai = 0; ai < 2; ++ai)
#pragma unroll
            for (int m = 0; m < 4; ++m) { const int row = rowb + ai * 128 + m * 16; mean[ai][m] = stats[2 * row]; rstd[ai][m] = stats[2 * row + 1]; }
#pragma unroll
        for (int bj = 0; bj < 2; ++bj)
#pragma unroll
            for (int n = 0; n < 2; ++n) { const int col = col0 + bj * 128 + n * 16; const f32x4 gt = 1.0f + *(const f32x4*)(ada + b * 6144 + 5120 + col);
                const f32x4 g = *(const f32x4*)(p->ln_attn_g + col) * DN_ALPHA, bb = *(const f32x4*)(p->ln_attn_b + col) * DN_ALPHA;
#pragma unroll
                for (int ai = 0; ai < 2; ++ai)
#pragma unroll
                    for (int m = 0; m < 4; ++m) { f32x4* o = (f32x4*)(p->out + (size_t)(rowb + ai * 128 + m * 16) * D + col);
                        *o = ((*o) - mean[ai][m]) * rstd[ai][m] * g + bb + gt * acc[ai][bj][m][n]; } }
    }
};
__device__ __forceinline__ float dpp_shr1(float v) { const int i = __builtin_bit_cast(int, v); return __builtin_bit_cast(float, __builtin_amdgcn_update_dpp(i, i, 0x111, 0xf, 0xf, false)); }
struct EpiUpConv {
    static constexpr bool PERM = true, AFTER_DRAIN = false, APERM = true;
    const Params* p; bf16_t* ACT; PG8_LAS float* xl;
    __device__ __forceinline__ void operator()(const f32x4 (&acc)[2][2][4][2], const pg8::Unit& u, int wr, int wc, int fr, int fq) const {
        const float* cw = p->conv_w; const float* cbias = p->conv_b;
        const int j0 = u.pn * 128 + wc * 32 + 8 * fq;
        PG8_LAS float* xs = xl + (wc * 4 + fq) * 32;
        if (wr == 0 && fr == 15) {
#pragma unroll
            for (int sl = 0; sl < 2; ++sl)
#pragma unroll
                for (int bj = 0; bj < 2; ++bj)
#pragma unroll
                    for (int n = 0; n < 2; ++n) *(PG8_LAS f32x4*)(xs + sl * 16 + bj * 8 + n * 4) = acc[1][bj][2 + sl][n];
        }
        asm volatile("s_waitcnt lgkmcnt(0)" ::: "memory"); __builtin_amdgcn_s_barrier(); asm volatile("" ::: "memory");
        const int rho0 = 128 * wr + 8 * fr, t0 = 254 * u.pm - 2 + rho0;
#pragma unroll
        for (int n = 0; n < 2; ++n) {
            const int ja = j0 + 4 * n;
            const f32x4 wa0 = *(const f32x4*)(cw + ja), wa1 = *(const f32x4*)(cw + F2 + ja), wa2 = *(const f32x4*)(cw + 2 * F2 + ja), ba = *(const f32x4*)(cbias + ja);
            const f32x4 wb0 = *(const f32x4*)(cw + F + ja), wb1 = *(const f32x4*)(cw + F2 + F + ja), wb2 = *(const f32x4*)(cw + 2 * F2 + F + ja), bb = *(const f32x4*)(cbias + F + ja);
            f32x4 am1, am2, bm1, bm2;
#pragma unroll
            for (int q = 0; q < 4; ++q) { am1[q] = dpp_shr1(acc[1][0][3][n][q]); am2[q] = dpp_shr1(acc[1][0][2][n][q]); bm1[q] = dpp_shr1(acc[1][1][3][n][q]); bm2[q] = dpp_shr1(acc[1][1][2][n][q]); }
            if (fr == 0 && wr == 1) { am2 = *(const PG8_LAS f32x4*)(xs + n * 4); bm2 = *(const PG8_LAS f32x4*)(xs + 8 + n * 4); am1 = *(const PG8_LAS f32x4*)(xs + 16 + n * 4); bm1 = *(const PG8_LAS f32x4*)(xs + 24 + n * 4); }
#pragma unroll
            for (int s = 0; s < 8; ++s) {
                const f32x4 xa = acc[s >> 2][0][s & 3][n], xb = acc[s >> 2][1][s & 3][n];
                const int t = t0 + s, sp = t & (SEQ - 1);
                const float f1 = sp >= 1 ? 1.f : 0.f, f2 = sp >= 2 ? 1.f : 0.f;
                const f32x4 ca = ba + wa2 * xa + (wa1 * am1) * f1 + (wa0 * am2) * f2;
                const f32x4 cb = bb + wb2 * xb + (wb1 * bm1) * f1 + (wb0 * bm2) * f2;
                float act[4];
#pragma unroll
                for (int q = 0; q < 4; ++q) act[q] = ca[q] * __builtin_amdgcn_rcpf(1.0f + __builtin_amdgcn_exp2f(-1.4426950408889634f * ca[q])) * cb[q];
                const unsigned w0 = cvtpk(act[0], act[1]), w1 = cvtpk(act[2], act[3]);
                if (rho0 + s >= 2 && t < M) *(u32x2*)(ACT + (size_t)t * F + ja) = (u32x2){w0, w1};
                am2 = am1; am1 = xa; bm2 = bm1; bm1 = xb;
            }
        }
    }
};
template <class Epi> __device__ __forceinline__ void gemm_pg8(unsigned char* lds, const bf16_t* A, const bf16_t* Bt, int Mrows, int N, int K, const Epi& e) {
    pg8::Gemm g{A, Bt, Mrows, N, K, 256}; pg8::StaticOrder S; S.init(Mrows, N, (int)gridDim.x, (int)blockIdx.x);
    pg8::gemm_phase<Epi, pg8::StaticOrder, true, true>((PG8_LAS unsigned char*)lds, g, S, e);
}

__device__ void phase_attn_naive(const Params& p, float* DIFF, int bid, int nb) {
    const bf16_t* DQ = (const bf16_t*)(p.ws + WS_DQ); const bf16_t* DK = (const bf16_t*)(p.ws + WS_DK); const bf16_t* DV = (const bf16_t*)(p.ws + WS_DV);
    const float lam = lambda_full(p);
    const int total = BATCH * NH * SEQ * 4;
    for (int w = bid * blockDim.x + threadIdx.x; w < total; w += nb * blockDim.x) {
        const int sl = w & 3, bh = (w >> 2) & 15, i = SEQ - 1 - (w >> 6), b = bh >> 2, h = bh & 3;
        const size_t rowq = (size_t)b * SEQ + i;
        float o0[32];
#pragma unroll
        for (int mp = 0; mp < 2; ++mp) {
            float q[64];
            { const u32x4* qp = (const u32x4*)(DQ + rowq * 512 + h * 128 + mp * 64);
#pragma unroll
              for (int c8 = 0; c8 < 8; ++c8) { const u32x4 u = qp[c8];
                  q[8 * c8 + 0] = bflo(u.x); q[8 * c8 + 1] = bfhi(u.x); q[8 * c8 + 2] = bflo(u.y); q[8 * c8 + 3] = bfhi(u.y);
                  q[8 * c8 + 4] = bflo(u.z); q[8 * c8 + 5] = bfhi(u.z); q[8 * c8 + 6] = bflo(u.w); q[8 * c8 + 7] = bfhi(u.w); } }
            float o[32];
#pragma unroll
            for (int e = 0; e < 32; ++e) o[e] = 0.f;
            float mx = -INFINITY, l = 0.f;
            for (int j = 0; j <= i; ++j) {
                const size_t rowk = (size_t)b * SEQ + j;
                const u32x4* kp = (const u32x4*)(DK + rowk * 512 + h * 128 + mp * 64);
                float s0 = 0.f, s1 = 0.f;
#pragma unroll
                for (int c8 = 0; c8 < 8; ++c8) { const u32x4 u = kp[c8];
                    s0 += q[8 * c8 + 0] * bflo(u.x); s1 += q[8 * c8 + 1] * bfhi(u.x); s0 += q[8 * c8 + 2] * bflo(u.y); s1 += q[8 * c8 + 3] * bfhi(u.y);
                    s0 += q[8 * c8 + 4] * bflo(u.z); s1 += q[8 * c8 + 5] * bfhi(u.z); s0 += q[8 * c8 + 6] * bflo(u.w); s1 += q[8 * c8 + 7] * bfhi(u.w); }
                const float s = s0 + s1;
                float pr;
                if (s > mx) { const float f = exp2f(mx - s); l = l * f + 1.f;
#pragma unroll
                    for (int e = 0; e < 32; ++e) o[e] *= f;
                    mx = s; pr = 1.f; }
                else { pr = exp2f(s - mx); l += pr; }
                const u32x4* vp = (const u32x4*)(DV + rowk * 512 + h * 128 + sl * 32);
#pragma unroll
                for (int c8 = 0; c8 < 4; ++c8) { const u32x4 u = vp[c8];
                    o[8 * c8 + 0] += pr * bflo(u.x); o[8 * c8 + 1] += pr * bfhi(u.x); o[8 * c8 + 2] += pr * bflo(u.y); o[8 * c8 + 3] += pr * bfhi(u.y);
                    o[8 * c8 + 4] += pr * bflo(u.z); o[8 * c8 + 5] += pr * bfhi(u.z); o[8 * c8 + 6] += pr * bflo(u.w); o[8 * c8 + 7] += pr * bfhi(u.w); }
            }
            const float il = 1.0f / l;
            if (mp == 0) {
#pragma unroll
                for (int e = 0; e < 32; ++e) o0[e] = o[e] * il;
            } else {
                float* dp = DIFF + rowq * 512 + h * 128 + sl * 32;
#pragma unroll
                for (int e = 0; e < 32; e += 4) *(f32x4*)(dp + e) = (f32x4){o0[e] - lam * o[e] * il, o0[e + 1] - lam * o[e + 1] * il, o0[e + 2] - lam * o[e + 2] * il, o0[e + 3] - lam * o[e + 3] * il};
            }
        }
    }
}

__device__ void phase_gla_naive(const Params& p, float* GO, int bid, int nb) {
    const bf16_t* GQ = (const bf16_t*)(p.ws + WS_GQ); const bf16_t* GK = (const bf16_t*)(p.ws + WS_GK); const bf16_t* GV = (const bf16_t*)(p.ws + WS_GV);
    const float* GLOG = (const float*)(p.ws + WS_GLOG);
    for (int w = bid * blockDim.x + threadIdx.x; w < BATCH * NH * 128; w += nb * blockDim.x) {
        const int dv = w & 127, bh = w >> 7, b = bh >> 2, h = bh & 3;
        float s[64];
#pragma unroll
        for (int d = 0; d < 64; ++d) s[d] = 0.f;
        for (int t = 0; t < SEQ; ++t) {
            const size_t row = (size_t)b * SEQ + t;
            const float v = bf2f(GV[row * 512 + h * 128 + dv]);
            const u32x4* qp = (const u32x4*)(GQ + row * 256 + h * 64); const u32x4* kp = (const u32x4*)(GK + row * 256 + h * 64);
            const f32x4* gp = (const f32x4*)(GLOG + row * 256 + h * 64);
            float o = 0.f;
#pragma unroll
            for (int c8 = 0; c8 < 8; ++c8) {
                const u32x4 qu = qp[c8], ku = kp[c8]; const f32x4 g0 = gp[2 * c8], g1 = gp[2 * c8 + 1];
                const float qf[8] = {bflo(qu.x), bfhi(qu.x), bflo(qu.y), bfhi(qu.y), bflo(qu.z), bfhi(qu.z), bflo(qu.w), bfhi(qu.w)};
                const float kf[8] = {bflo(ku.x), bfhi(ku.x), bflo(ku.y), bfhi(ku.y), bflo(ku.z), bfhi(ku.z), bflo(ku.w), bfhi(ku.w)};
                const float gf[8] = {g0[0], g0[1], g0[2], g0[3], g1[0], g1[1], g1[2], g1[3]};
#pragma unroll
                for (int e = 0; e < 8; ++e) { const int d = 8 * c8 + e; s[d] = __expf(gf[e]) * s[d] + kf[e] * v; o += qf[e] * s[d]; }
            }
            GO[row * 512 + h * 128 + dv] = o;
        }
    }
}

__device__ void phase_mixprep(const Params& p, const float* DIFF, const float* GO, int bid, int nb) {
    bf16_t* MIX = (bf16_t*)(p.ws + WS_MIX); const bf16_t* GR = (const bf16_t*)(p.ws + WS_GR);
    const int lane = threadIdx.x & 63, wpb = blockDim.x >> 6, gw = bid * wpb + (threadIdx.x >> 6), ngw = nb * wpb;
    for (int m = gw; m < M; m += ngw) {
        const bool gla = lane >= 32; const int cb = 16 * (lane & 31);
        if (!gla && !DIFF) continue;
        const float* src = (gla ? GO : DIFF) + (size_t)m * 512 + cb;
        float v[16]; float ss = 0.f;
#pragma unroll
        for (int e = 0; e < 16; e += 4) { const f32x4 t = *(const f32x4*)(src + e); v[e] = t[0]; v[e + 1] = t[1]; v[e + 2] = t[2]; v[e + 3] = t[3]; ss += (t[0] * t[0] + t[1] * t[1]) + (t[2] * t[2] + t[3] * t[3]); }
        ss += __shfl_xor(ss, 1); ss += __shfl_xor(ss, 2); ss += __shfl_xor(ss, 4);
        const float r = 1.0f / sqrtf(ss * (1.f / 128.f) + LN_EPS);
        const float* nw = (gla ? p.gla_norm_w : p.diff_norm_w) + (cb & 127);
        unsigned w[8];
#pragma unroll
        for (int e = 0; e < 16; e += 2) {
            float a = v[e] * r * nw[e], c = v[e + 1] * r * nw[e + 1];
            if (gla) { a *= bf2f(GR[(size_t)m * 512 + cb + e]); c *= bf2f(GR[(size_t)m * 512 + cb + e + 1]); }
            else { a *= (1.0f - LAMBDA_INIT); c *= (1.0f - LAMBDA_INIT); }
            w[e >> 1] = pk2(a, c);
        }
        u32x4* dst = (u32x4*)(MIX + (size_t)m * D + (gla ? 512 : 0) + cb);
        dst[0] = (u32x4){w[0], w[1], w[2], w[3]}; dst[1] = (u32x4){w[4], w[5], w[6], w[7]};
    }
}

__device__ void phase_convact(const Params& p, int half, int bid, int nb) {
    const bf16_t* UP = (const bf16_t*)(p.ws + WS_UPH); bf16_t* ACT = (bf16_t*)(p.ws + WS_ACTH);
    const int total = 8192 * (F / 4);
    for (int e = bid * blockDim.x + threadIdx.x; e < total; e += nb * blockDim.x) {
        const int t = e / (F / 4), j0 = (e % (F / 4)) * 4, s = (t + half * 8192) & (SEQ - 1);
        const int ca = 256 * (j0 >> 7) + (j0 & 127), cbb = ca + 128;
        float a[4], bq[4];
#pragma unroll
        for (int q = 0; q < 4; ++q) { a[q] = p.conv_b[j0 + q]; bq[q] = p.conv_b[F + j0 + q]; }
#pragma unroll
        for (int k = 0; k < 3; ++k) {
            const int dt = 2 - k;
            if (s - dt >= 0) {
                const u32x2 ua = *(const u32x2*)(UP + (size_t)(t - dt) * F2 + ca), ub = *(const u32x2*)(UP + (size_t)(t - dt) * F2 + cbb);
                const float xa[4] = {bflo(ua.x), bfhi(ua.x), bflo(ua.y), bfhi(ua.y)}, xb[4] = {bflo(ub.x), bfhi(ub.x), bflo(ub.y), bfhi(ub.y)};
#pragma unroll
                for (int q = 0; q < 4; ++q) { a[q] += p.conv_w[k * F2 + j0 + q] * xa[q]; bq[q] += p.conv_w[k * F2 + F + j0 + q] * xb[q]; }
            }
        }
        u32x2 w; w.x = pk2(silu_f(a[0]) * bq[0], silu_f(a[1]) * bq[1]); w.y = pk2(silu_f(a[2]) * bq[2], silu_f(a[3]) * bq[3]);
        *(u32x2*)(ACT + (size_t)t * F + j0) = w;
    }
}

namespace attn {
#define ATT_LAS __attribute__((address_space(3)))
typedef float f32x16 __attribute__((ext_vector_type(16)));
typedef short s16x4 __attribute__((ext_vector_type(4)));
typedef short v4i16_t __attribute__((ext_vector_type(4)));
constexpr int KVBUF = 32768, OFF_K0 = 0, OFF_K1 = 8192, OFF_V = 16384, OFF_WSF = 131072;
constexpr float THR = 6.0f, NEG = -1e30f;
__device__ __forceinline__ int crow(int r, int hi) { return (r & 3) + 8 * (r >> 2) + 4 * hi; }
__device__ __forceinline__ void glds16(const void* g, ATT_LAS unsigned char* dst) {
    const unsigned d = (unsigned)__builtin_amdgcn_readfirstlane((int)(unsigned)(uintptr_t)dst); unsigned keep;
    asm volatile("s_mov_b32 %0, m0\n\ts_mov_b32 m0, %2\n\ts_nop 0\n\tglobal_load_lds_dwordx4 %1, off\n\ts_mov_b32 m0, %0" : "=&s"(keep) : "v"(g), "s"(d) : "memory"); }
__device__ __forceinline__ s16x4 vtr(const ATT_LAS unsigned char* p) { return __builtin_bit_cast(s16x4, __builtin_amdgcn_ds_read_tr16_b64_v4i16((ATT_LAS v4i16_t*)p)); }
__device__ __forceinline__ float swap_max(float m) { auto rr = __builtin_amdgcn_permlane32_swap(__float_as_uint(m), __float_as_uint(m), false, false); return fmaxf(__uint_as_float(rr[0]), __uint_as_float(rr[1])); }
__device__ __forceinline__ float swap_sum(float m) { auto rr = __builtin_amdgcn_permlane32_swap(__float_as_uint(m), __float_as_uint(m), false, false); return __uint_as_float(rr[0]) + __uint_as_float(rr[1]); }

__device__ __forceinline__ void stage_tile(ATT_LAS unsigned char* buf, const bf16_t* Kg, const bf16_t* Vg, int t, int wid, int lane) {
    const size_t ro = (size_t)t * 64 * 512;
    glds16(Kg + ro + (size_t)lane * 512 + wid * 8, buf + OFF_K0 + wid * 1024);
    glds16(Kg + ro + (size_t)lane * 512 + 64 + wid * 8, buf + OFF_K1 + wid * 1024);
#pragma unroll
    for (int i = 0; i < 2; ++i) { const int pp = wid + 8 * i;
        glds16(Vg + ro + (size_t)(16 * (pp & 3) + (lane >> 2)) * 512 + (pp >> 2) * 32 + (lane & 3) * 8, buf + OFF_V + pp * 1024); }
}

__device__ __forceinline__ void step_a(const bool MASK, const ATT_LAS unsigned char* buf, int mp, int r32, int hi, const bf16x8 (&qr)[4], f32x16 (&o)[4], float& mref, float& lsum,
                                       ATT_LAS float* wsf, int key0, int qabs, bf16x8 (&pa)[4]) {
    const ATT_LAS unsigned char* kp = buf + (mp ? OFF_K1 : OFF_K0) + hi * 1024 + r32 * 16;
    f32x16 p0 = {}, p1 = {};
#pragma unroll
    for (int d0 = 0; d0 < 4; ++d0) {
        const bf16x8 a0 = *(const ATT_LAS bf16x8*)(kp + d0 * 2048), a1 = *(const ATT_LAS bf16x8*)(kp + d0 * 2048 + 512);
        p0 = __builtin_amdgcn_mfma_f32_32x32x16_bf16(a0, qr[d0], p0, 0, 0, 0);
        p1 = __builtin_amdgcn_mfma_f32_32x32x16_bf16(a1, qr[d0], p1, 0, 0, 0);
    }
    if (MASK) {
#pragma unroll
        for (int r = 0; r < 16; ++r) { const int key = key0 + crow(r, hi); if (key > qabs) p0[r] = NEG; if (key + 32 > qabs) p1[r] = NEG; }
    }
    float m = fmaxf(p0[0], p1[0]);
#pragma unroll
    for (int r = 1; r < 16; ++r) m = fmaxf(m, fmaxf(p0[r], p1[r]));
    const float rm = swap_max(m);
    if (__any(rm > mref + THR)) {
        const float mnew = fmaxf(mref, rm), f = __builtin_amdgcn_exp2f(mref - mnew);
        lsum *= f; mref = mnew;
        if (hi == 0) wsf[r32] = f;
#pragma unroll
        for (int g = 0; g < 4; ++g) { float f4[4];
#pragma unroll
            for (int i = 0; i < 4; ++i) f4[i] = wsf[8 * g + 4 * hi + i];
#pragma unroll
            for (int d0 = 0; d0 < 4; ++d0)
#pragma unroll
                for (int i = 0; i < 4; ++i) o[d0][4 * g + i] *= f4[i]; }
    }
    float s = 0.f;
#pragma unroll
    for (int r = 0; r < 16; ++r) { p0[r] = __builtin_amdgcn_exp2f(p0[r] - mref); p1[r] = __builtin_amdgcn_exp2f(p1[r] - mref); s += p0[r] + p1[r]; }
    lsum += s;
    { u32x4 w;
      w.x = cvtpk(p0[0], p0[1]); w.y = cvtpk(p0[2], p0[3]); w.z = cvtpk(p0[4], p0[5]); w.w = cvtpk(p0[6], p0[7]); pa[0] = __builtin_bit_cast(bf16x8, w);
      w.x = cvtpk(p0[8], p0[9]); w.y = cvtpk(p0[10], p0[11]); w.z = cvtpk(p0[12], p0[13]); w.w = cvtpk(p0[14], p0[15]); pa[1] = __builtin_bit_cast(bf16x8, w);
      w.x = cvtpk(p1[0], p1[1]); w.y = cvtpk(p1[2], p1[3]); w.z = cvtpk(p1[4], p1[5]); w.w = cvtpk(p1[6], p1[7]); pa[2] = __builtin_bit_cast(bf16x8, w);
      w.x = cvtpk(p1[8], p1[9]); w.y = cvtpk(p1[10], p1[11]); w.z = cvtpk(p1[12], p1[13]); w.w = cvtpk(p1[14], p1[15]); pa[3] = __builtin_bit_cast(bf16x8, w); }
}
__device__ __forceinline__ void step_b(const ATT_LAS unsigned char* buf, int lane, int hi, const bf16x8 (&pa)[4], f32x16 (&o)[4]) {
    const ATT_LAS unsigned char* vp = buf + OFF_V + ((lane >> 4) & 1) * 32 + (lane & 3) * 8 + (4 * hi + ((lane & 15) >> 2)) * 64;
#pragma unroll
    for (int d0 = 0; d0 < 4; ++d0) {
#pragma unroll
        for (int ks = 0; ks < 4; ++ks) {
            const s16x4 lo = vtr(vp + d0 * 4096 + ks * 1024), hh = vtr(vp + d0 * 4096 + ks * 1024 + 512);
            const bf16x8 vb = (bf16x8){lo[0], lo[1], lo[2], lo[3], hh[0], hh[1], hh[2], hh[3]};
            o[d0] = __builtin_amdgcn_mfma_f32_32x32x16_bf16(pa[ks], vb, o[d0], 0, 0, 0);
        }
    }
}

__device__ __forceinline__ void attn_unit(const Params& p, ATT_LAS unsigned char* lds, int b, int h, int qb, float lam) {
    int tid_ = threadIdx.x; asm volatile("" : "+v"(tid_));
    const int tid = tid_, lane = tid & 63, r32 = lane & 31, hi = lane >> 5, wid = __builtin_amdgcn_readfirstlane(tid >> 6), mp = wid >> 2, wq = wid & 3;
    const int q0 = qb * 128, NT = 2 * (qb + 1);
    const size_t rowbase = (size_t)b * SEQ;
    const bf16_t* Kg = (const bf16_t*)(p.ws + WS_DK) + rowbase * 512 + h * 128;
    const bf16_t* Vg = (const bf16_t*)(p.ws + WS_DV) + rowbase * 512 + h * 128;
    const bf16_t* Qw = (const bf16_t*)(p.ws + WS_DQ) + (rowbase + q0 + wq * 32 + r32) * 512 + h * 128 + mp * 64;
    ATT_LAS float* wsf = (ATT_LAS float*)(lds + OFF_WSF) + wid * 64;
    asm volatile("s_waitcnt vmcnt(0)" ::: "memory");
    stage_tile(lds, Kg, Vg, 0, wid, lane); stage_tile(lds + KVBUF, Kg, Vg, 1, wid, lane);
    bf16x8 qr[4];
#pragma unroll
    for (int d0 = 0; d0 < 4; ++d0) qr[d0] = *(const bf16x8*)(Qw + d0 * 16 + hi * 8);
    __builtin_amdgcn_s_waitcnt(0x0F70);
    f32x16 o[4];
#pragma unroll
    for (int d0 = 0; d0 < 4; ++d0) o[d0] = f32x16{};
    float mref = NEG, lsum = 0.f;
    const int qabs = q0 + wq * 32 + r32;
    bf16x8 pa[4];
#pragma unroll
    for (int k = 0; k < 4; ++k) pa[k] = bf16x8{};
    for (int t = 0; t < NT; ++t) {
        if (t + 1 < NT) asm volatile("s_waitcnt vmcnt(4)" ::: "memory"); else asm volatile("s_waitcnt vmcnt(0)" ::: "memory");
        __syncthreads();
        if (t + 2 < NT) stage_tile(lds + ((t + 2) & 3) * KVBUF, Kg, Vg, t + 2, wid, lane);
        const bool skip = (t == NT - 1 && wq < 2);
        if (mp == 1 && t > 0) step_b(lds + ((t - 1) & 3) * KVBUF, lane, hi, pa, o);
        if (!skip) step_a(t >= NT - 2, lds + (t & 3) * KVBUF, mp, r32, hi, qr, o, mref, lsum, wsf, t * 64, qabs, pa);
        if (mp == 0 && !skip) step_b(lds + (t & 3) * KVBUF, lane, hi, pa, o);
    }
    if (mp == 1 && wq >= 2) step_b(lds + ((NT - 1) & 3) * KVBUF, lane, hi, pa, o);
    const float linv = 1.0f / swap_sum(lsum);
    if (hi == 0) wsf[r32] = linv;
#pragma unroll
    for (int g = 0; g < 4; ++g) { float f4[4];
#pragma unroll
        for (int i = 0; i < 4; ++i) f4[i] = wsf[8 * g + 4 * hi + i];
#pragma unroll
        for (int d0 = 0; d0 < 4; ++d0)
#pragma unroll
            for (int i = 0; i < 4; ++i) o[d0][4 * g + i] *= f4[i]; }
    ATT_LAS float* xch = (ATT_LAS float*)(lds + (NT & 3) * KVBUF) + (size_t)wq * 4 * 16 * 64 + lane;
    if (mp == 1) {
#pragma unroll
        for (int d0 = 0; d0 < 4; ++d0)
#pragma unroll
            for (int r = 0; r < 16; ++r) xch[(d0 * 16 + r) * 64] = o[d0][r];
    }
    __syncthreads();
    if (mp == 0) {
        float nw[4];
#pragma unroll
        for (int d0 = 0; d0 < 4; ++d0) nw[d0] = p.diff_norm_w[32 * d0 + r32] * (1.0f - LAMBDA_INIT);
        bf16_t* Ow = (bf16_t*)(p.ws + WS_MIX) + (rowbase + q0 + wq * 32) * D + h * 128 + r32;
#pragma unroll
        for (int r = 0; r < 16; ++r) {
            float dsq = 0.f; float dv[4];
#pragma unroll
            for (int d0 = 0; d0 < 4; ++d0) { dv[d0] = o[d0][r] - lam * xch[(d0 * 16 + r) * 64]; dsq += dv[d0] * dv[d0]; }
            dsq += __shfl_xor(dsq, 1); dsq += __shfl_xor(dsq, 2); dsq += __shfl_xor(dsq, 4); dsq += __shfl_xor(dsq, 8); dsq += __shfl_xor(dsq, 16);
            const float rs = 1.0f / sqrtf(dsq * (1.0f / 128.0f) + LN_EPS);
            bf16_t* orow = Ow + (size_t)crow(r, hi) * D;
#pragma unroll
            for (int d0 = 0; d0 < 4; ++d0) orow[32 * d0] = (bf16_t)f2bf(dv[d0] * rs * nw[d0]);
        }
    }
    __syncthreads();
}

__device__ void phase_attn(const Params& p, unsigned char* lds_generic) {
    ATT_LAS unsigned char* lds = (ATT_LAS unsigned char*)lds_generic;
    const float lam = lambda_full(p);
    const int G = gridDim.x, bx = blockIdx.x, vcu = (G % 8 == 0) ? (bx % 8) * (G / 8) + bx / 8 : bx;
    for (int item = vcu; item < 256; item += G) {
        const int bh = item >> 4, s = item & 15;
        attn_unit(p, lds, bh >> 2, bh & 3, 31 - s, lam);
        attn_unit(p, lds, bh >> 2, bh & 3, s, lam);
    }
}
}

namespace gla {
#define GL_LAS __attribute__((address_space(3)))
typedef float f32x16 __attribute__((ext_vector_type(16)));
typedef short s16x4 __attribute__((ext_vector_type(4)));
typedef short v4i16_t __attribute__((ext_vector_type(4)));
constexpr size_t WS_DEC = WS_BIG + 176 * MiB;
constexpr size_t WS_GB = 32 * MiB + 65536;
constexpr size_t WS_SB = 48 * MiB + 65536;
__device__ __forceinline__ s16x4 vtr(const GL_LAS unsigned char* p) { return __builtin_bit_cast(s16x4, __builtin_amdgcn_ds_read_tr16_b64_v4i16((GL_LAS v4i16_t*)p)); }
__device__ __forceinline__ bf16x8 cat8(s16x4 lo, s16x4 hh) { return (bf16x8){lo[0], lo[1], lo[2], lo[3], hh[0], hh[1], hh[2], hh[3]}; }
__device__ __forceinline__ int crow(int r, int hi) { return (r & 3) + 8 * (r >> 2) + 4 * hi; }

__device__ __forceinline__ void stage_v(GL_LAS unsigned char* VI, const bf16_t* GVh  , int tid) {
    const int tok = tid >> 3, c8 = tid & 7;
    const u32x4* src = (const u32x4*)(GVh + (size_t)tok * 512 + c8 * 16);
    const u32x4 a = src[0], b = src[1];
    GL_LAS unsigned char* dst = VI + (c8 >> 1) * 4096 + tok * 64 + (c8 & 1) * 32;
    *(GL_LAS u32x4*)dst = a; *(GL_LAS u32x4*)(dst + 16) = b;
}

__device__ __forceinline__ void g1_unit(const Params& p, GL_LAS unsigned char* lds, int bh, int c) {
    int tid_ = threadIdx.x; asm volatile("" : "+v"(tid_));
    const int tid = tid_, lane = tid & 63, wid = __builtin_amdgcn_readfirstlane(tid >> 6), hi = lane >> 5, r32 = lane & 31;
    const int b = bh >> 2, h = bh & 3; const size_t row0 = (size_t)b * SEQ + c * 64;
    const float* GLOG = (const float*)(p.ws + WS_GLOG) + row0 * 256 + h * 64; float* GBo = (float*)(p.ws + WS_GB) + row0 * 256 + h * 64;
    const bf16_t* GK = (const bf16_t*)(p.ws + WS_GK) + row0 * 256 + h * 64;
    const bf16_t* GV = (const bf16_t*)(p.ws + WS_GV) + row0 * 512 + h * 128;
    float* DEC = (float*)(p.ws + WS_DEC) + (size_t)(bh * 64 + c) * 64;
    GL_LAS float* SEG = (GL_LAS float*)lds; GL_LAS unsigned char* KH = lds + 4096; GL_LAS unsigned char* VI = lds + 16384;
    const int d = tid & 63, seg = tid >> 6;
    float g[8], kv[8];
#pragma unroll
    for (int i = 0; i < 8; ++i) { g[i] = GLOG[(size_t)(seg * 8 + i) * 256 + d]; kv[i] = bf2f(GK[(size_t)(seg * 8 + i) * 256 + d]); }
    stage_v(VI, GV, tid);
#pragma unroll
    for (int i = 1; i < 8; ++i) g[i] += g[i - 1];
    SEG[seg * 64 + d] = g[7];
    __syncthreads();
    float pre = 0.f, tot = 0.f;
#pragma unroll
    for (int s = 0; s < 8; ++s) { const float v = SEG[s * 64 + d]; pre += (s < seg) ? v : 0.f; tot += v; }
#pragma unroll
    for (int i = 0; i < 8; ++i) { g[i] += pre; GBo[(size_t)(seg * 8 + i) * 256 + d] = g[i];
        *(GL_LAS bf16_t*)(KH + (d >> 5) * 4096 + (seg * 8 + i) * 64 + (d & 31) * 2) = (bf16_t)f2bf(kv[i] * __expf(tot - g[i])); }
    if (seg == 0) DEC[d] = __expf(tot);
    __syncthreads();
    const int dblk = wid >> 2, dvb = wid & 3;
    const int toff = ((lane & 15) >> 2) * 64 + ((lane >> 4) & 1) * 32 + (lane & 3) * 8 + hi * 512;
    const GL_LAS unsigned char* ap = KH + dblk * 4096 + toff; const GL_LAS unsigned char* bp = VI + dvb * 4096 + toff;
    f32x16 acc = {};
#pragma unroll
    for (int ks = 0; ks < 4; ++ks) {
        const bf16x8 a = cat8(vtr(ap + ks * 1024), vtr(ap + ks * 1024 + 256)), bb = cat8(vtr(bp + ks * 1024), vtr(bp + ks * 1024 + 256));
        acc = __builtin_amdgcn_mfma_f32_32x32x16_bf16(a, bb, acc, 0, 0, 0);
    }
    float* U = (float*)(p.ws + WS_GLU) + (size_t)(bh * 64 + c) * 8192 + dvb * 32 + r32;
#pragma unroll
    for (int r = 0; r < 16; ++r) U[(size_t)(dblk * 32 + crow(r, hi)) * 128] = acc[r];
    __syncthreads();
}
__device__ void phase_g1(const Params& p, unsigned char* lds_generic) {
    GL_LAS unsigned char* lds = (GL_LAS unsigned char*)lds_generic;
    const int G = gridDim.x, bx = blockIdx.x, vcu = (G % 8 == 0) ? (bx % 8) * (G / 8) + bx / 8 : bx;
    for (int u = vcu; u < 1024; u += G) g1_unit(p, lds, u >> 6, u & 63);
}
__device__ void phase_g2(const Params& p, int bid, int nb) {
    const float* GLU = (const float*)(p.ws + WS_GLU); const float* DEC = (const float*)(p.ws + WS_DEC);
    for (int e = bid * blockDim.x + threadIdx.x; e < 16 * 8192; e += nb * blockDim.x) {
        const int bh = e >> 13, el = e & 8191, d = el >> 7;
        const float* base = GLU + (size_t)bh * 64 * 8192 + el; const float* dec = DEC + (size_t)bh * 64 * 64 + d;
        bf16_t* sb = (bf16_t*)(p.ws + WS_SB) + (size_t)bh * 64 * 8192 + el;
        float s = 0.f;
        for (int c0 = 0; c0 < 64; c0 += 16) {
            float u[16], dc[16];
#pragma unroll
            for (int i = 0; i < 16; ++i) { u[i] = base[(size_t)(c0 + i) * 8192]; dc[i] = dec[(c0 + i) * 64]; }
#pragma unroll
            for (int i = 0; i < 16; ++i) { sb[(size_t)(c0 + i) * 8192] = (bf16_t)f2bf(s); s = dc[i] * s + u[i]; }
        }
    }
}
__device__ __forceinline__ void g3_unit(const Params& p, GL_LAS unsigned char* lds, int bh, int c) {
    int tid_ = threadIdx.x; asm volatile("" : "+v"(tid_));
    const int tid = tid_, lane = tid & 63, wid = __builtin_amdgcn_readfirstlane(tid >> 6), hi = lane >> 5, r32 = lane & 31;
    const int b = bh >> 2, h = bh & 3; const size_t row0 = (size_t)b * SEQ + c * 64;
    const float* GB = (const float*)(p.ws + WS_GB) + row0 * 256 + h * 64;
    const bf16_t* GQ = (const bf16_t*)(p.ws + WS_GQ) + row0 * 256 + h * 64; const bf16_t* GK = (const bf16_t*)(p.ws + WS_GK) + row0 * 256 + h * 64;
    const bf16_t* GV = (const bf16_t*)(p.ws + WS_GV) + row0 * 512 + h * 128; const bf16_t* GR = (const bf16_t*)(p.ws + WS_GR) + row0 * 512 + h * 128;
    const bf16_t* S = (const bf16_t*)(p.ws + WS_SB) + (size_t)(bh * 64 + c) * 8192;
    GL_LAS unsigned char* QI = lds; GL_LAS unsigned char* KI = lds + 8192; GL_LAS unsigned char* VI = lds + 16384; GL_LAS unsigned char* SI = lds + 32768;
    GL_LAS float* OX = (GL_LAS float*)(lds + 49152);
    const int tok = tid >> 3, c8 = tid & 7;
    {
        const f32x4 b0 = *(const f32x4*)(GB + (size_t)tok * 256 + c8 * 8), b1 = *(const f32x4*)(GB + (size_t)tok * 256 + c8 * 8 + 4);
        const u32x4 qu = *(const u32x4*)(GQ + (size_t)tok * 256 + c8 * 8), ku = *(const u32x4*)(GK + (size_t)tok * 256 + c8 * 8);
        const float bv[8] = {b0[0], b0[1], b0[2], b0[3], b1[0], b1[1], b1[2], b1[3]};
        const float qf[8] = {bflo(qu.x), bfhi(qu.x), bflo(qu.y), bfhi(qu.y), bflo(qu.z), bfhi(qu.z), bflo(qu.w), bfhi(qu.w)};
        const float kf[8] = {bflo(ku.x), bfhi(ku.x), bflo(ku.y), bfhi(ku.y), bflo(ku.z), bfhi(ku.z), bflo(ku.w), bfhi(ku.w)};
        float qt[8], kt[8];
#pragma unroll
        for (int j = 0; j < 8; ++j) { qt[j] = qf[j] * __expf(bv[j]); kt[j] = kf[j] * __expf(-bv[j]); }
        *(GL_LAS u32x4*)(QI + c8 * 1024 + tok * 16) = (u32x4){cvtpk(qt[0], qt[1]), cvtpk(qt[2], qt[3]), cvtpk(qt[4], qt[5]), cvtpk(qt[6], qt[7])};
        *(GL_LAS u32x4*)(KI + c8 * 1024 + tok * 16) = (u32x4){cvtpk(kt[0], kt[1]), cvtpk(kt[2], kt[3]), cvtpk(kt[4], kt[5]), cvtpk(kt[6], kt[7])};
    }
    stage_v(VI, GV, tid);
    {
        const u32x4* sp = (const u32x4*)(S + (size_t)tok * 128 + c8 * 16);
        const u32x4 s0 = sp[0], s1 = sp[1];
        GL_LAS unsigned char* dst = SI + (c8 >> 1) * 4096 + tok * 64 + (c8 & 1) * 32;
        *(GL_LAS u32x4*)dst = s0; *(GL_LAS u32x4*)(dst + 16) = s1;
    }
    __syncthreads();
    const int ib = wid >> 2, dvb = wid & 3;
    bf16x8 qfr[4];
#pragma unroll
    for (int d0 = 0; d0 < 4; ++d0) qfr[d0] = *(const GL_LAS bf16x8*)(QI + (2 * d0 + hi) * 1024 + (32 * ib + r32) * 16);
    f32x16 o = {};
    const int tq = ((lane & 15) >> 2) * 64 + ((lane >> 4) & 1) * 32 + (lane & 3) * 8;
    const GL_LAS unsigned char* vp = VI + dvb * 4096 + tq + hi * 256;
    const GL_LAS unsigned char* sp2 = SI + dvb * 4096 + tq + hi * 512;
#pragma unroll
    for (int jb = 0; jb < 2; ++jb) {
        if (jb <= ib) {
            f32x16 pj = {};
#pragma unroll
            for (int d0 = 0; d0 < 4; ++d0) { const bf16x8 kf = *(const GL_LAS bf16x8*)(KI + (2 * d0 + hi) * 1024 + (32 * jb + r32) * 16);
                pj = __builtin_amdgcn_mfma_f32_32x32x16_bf16(kf, qfr[d0], pj, 0, 0, 0); }
            if (jb == ib) {
#pragma unroll
                for (int r = 0; r < 16; ++r) if (crow(r, hi) > r32) pj[r] = 0.f;
            }
            const bf16x8 pa0 = __builtin_bit_cast(bf16x8, (u32x4){cvtpk(pj[0], pj[1]), cvtpk(pj[2], pj[3]), cvtpk(pj[4], pj[5]), cvtpk(pj[6], pj[7])});
            const bf16x8 pa1 = __builtin_bit_cast(bf16x8, (u32x4){cvtpk(pj[8], pj[9]), cvtpk(pj[10], pj[11]), cvtpk(pj[12], pj[13]), cvtpk(pj[14], pj[15])});
            o = __builtin_amdgcn_mfma_f32_32x32x16_bf16(pa0, cat8(vtr(vp + (2 * jb) * 1024), vtr(vp + (2 * jb) * 1024 + 512)), o, 0, 0, 0);
            o = __builtin_amdgcn_mfma_f32_32x32x16_bf16(pa1, cat8(vtr(vp + (2 * jb + 1) * 1024), vtr(vp + (2 * jb + 1) * 1024 + 512)), o, 0, 0, 0);
        }
    }
#pragma unroll
    for (int d0 = 0; d0 < 4; ++d0) o = __builtin_amdgcn_mfma_f32_32x32x16_bf16(qfr[d0], cat8(vtr(sp2 + d0 * 1024), vtr(sp2 + d0 * 1024 + 256)), o, 0, 0, 0);
#pragma unroll
    for (int r = 0; r < 16; ++r) OX[(32 * ib + crow(r, hi)) * 132 + dvb * 32 + r32] = o[r];
    __syncthreads();
    {
        float v[16]; float ss = 0.f;
#pragma unroll
        for (int e = 0; e < 16; ++e) { v[e] = OX[tok * 132 + c8 * 16 + e]; ss += v[e] * v[e]; }
        ss += __shfl_xor(ss, 1); ss += __shfl_xor(ss, 2); ss += __shfl_xor(ss, 4);
        const float rs = 1.0f / sqrtf(ss * (1.0f / 128.0f) + LN_EPS);
        const u32x4 g0 = *(const u32x4*)(GR + (size_t)tok * 512 + c8 * 16), g1 = *(const u32x4*)(GR + (size_t)tok * 512 + c8 * 16 + 8);
        const float gr[16] = {bflo(g0.x), bfhi(g0.x), bflo(g0.y), bfhi(g0.y), bflo(g0.z), bfhi(g0.z), bflo(g0.w), bfhi(g0.w),
                              bflo(g1.x), bfhi(g1.x), bflo(g1.y), bfhi(g1.y), bflo(g1.z), bfhi(g1.z), bflo(g1.w), bfhi(g1.w)};
        const float* nw = p.gla_norm_w + c8 * 16; unsigned w[8];
#pragma unroll
        for (int e = 0; e < 16; e += 2) w[e >> 1] = cvtpk(v[e] * rs * nw[e] * gr[e], v[e + 1] * rs * nw[e + 1] * gr[e + 1]);
        u32x4* dst = (u32x4*)((bf16_t*)(p.ws + WS_MIX) + (row0 + tok) * D + 512 + h * 128 + c8 * 16);
        dst[0] = (u32x4){w[0], w[1], w[2], w[3]}; dst[1] = (u32x4){w[4], w[5], w[6], w[7]};
    }
    __syncthreads();
}
__device__ void phase_g3(const Params& p, unsigned char* lds_generic) {
    GL_LAS unsigned char* lds = (GL_LAS unsigned char*)lds_generic;
    const int G = gridDim.x, bx = blockIdx.x, vcu = (G % 8 == 0) ? (bx % 8) * (G / 8) + bx / 8 : bx;
    for (int u = vcu; u < 1024; u += G) g3_unit(p, lds, u >> 6, u & 63);
}
}

#define LAS __attribute__((address_space(3)))
#define XB_TMO      128
#define XB_XCNT(j)  (256  + 64 * (j))
#define XB_XSUB(j)  (1280 + 64 * (j))
#define XB_XGEN(j)  (2304 + 64 * (j))
#define XB_TOP      3328
#define XB_TOPGEN   3392
#define XCD_BAR_WORDS 3456
#define XB_SPIN_CAP (1u << 18)

__device__ __forceinline__ unsigned xb_ld(unsigned* p)              { return __hip_atomic_load(p, __ATOMIC_RELAXED, __HIP_MEMORY_SCOPE_AGENT); }
__device__ __forceinline__ unsigned xb_add(unsigned* p, unsigned v) { return __hip_atomic_fetch_add(p, v, __ATOMIC_RELAXED, __HIP_MEMORY_SCOPE_AGENT); }
__device__ __forceinline__ unsigned xb_xcc_id() { return (unsigned)__builtin_amdgcn_s_getreg((3 << 11) | 20) & 0xFu; }
#define XB_SPIN(cond, bar) do { unsigned _sp = 0; while (cond) { __builtin_amdgcn_s_sleep(1); \
    if ((++_sp & 255u) == 0u) { if (xb_ld(&(bar)[XB_TMO])) break; if (_sp > XB_SPIN_CAP) { atomicAdd(&(bar)[XB_TMO], 1u); break; } } } } while (0)

struct XcdBarrier {
    unsigned* bar; unsigned x;
    volatile LAS unsigned* st;
};

__device__ __forceinline__ XcdBarrier xcd_barrier_post(unsigned* bar, volatile LAS unsigned* st) {
    XcdBarrier b; b.bar = bar; b.x = xb_xcc_id(); b.st = st;
    if (threadIdx.x == 0) (void)xb_add(&bar[XB_XCNT(b.x)], 1u);
    return b;
}
__device__ __forceinline__ void xcd_barrier_complete(unsigned* bar, unsigned x, unsigned& nloc, unsigned& nx) {
    const unsigned G = gridDim.x * gridDim.y * gridDim.z;
    unsigned sum, cnt, mine, sp = 0u;
    for (;;) {
        sum = 0u; cnt = 0u; mine = 0u;
#pragma unroll
        for (unsigned j = 0; j < 16; ++j) { const unsigned c = xb_ld(&bar[XB_XCNT(j)]); sum += c; cnt += (c > 0u) ? 1u : 0u; mine = (j == x) ? c : mine; }
        if (sum == G) break;
        __builtin_amdgcn_s_sleep(1);
        if ((++sp & 255u) == 0u) { if (xb_ld(&bar[XB_TMO])) break; if (sp > XB_SPIN_CAP) { atomicAdd(&bar[XB_TMO], 1u); break; } }
    }
    nloc = mine > 0u ? mine : 1u; nx = cnt > 0u ? cnt : 1u;
}

__device__ __forceinline__ void xcd_barrier(const XcdBarrier& b) {
    asm volatile("s_waitcnt vmcnt(0)" ::: "memory");
    __syncthreads();
    if (threadIdx.x == 0) {
        unsigned* bar = b.bar;
        __builtin_amdgcn_s_waitcnt(0);
        unsigned nloc = b.st[0], nx = b.st[1];
        if (nloc == 0u) { xcd_barrier_complete(bar, b.x, nloc, nx); b.st[0] = nloc; b.st[1] = nx; }
        const unsigned old = xb_add(&bar[XB_XSUB(b.x)], 1u);
        const unsigned gen = old / nloc;
        if (old + 1u == (gen + 1u) * nloc) {
            __builtin_amdgcn_fence(__ATOMIC_RELEASE, "agent");
            asm volatile("s_waitcnt vmcnt(0)" ::: "memory");
            const unsigned og = xb_add(&bar[XB_TOP], 1u);
            const unsigned tg = og / nx;
            if (og + 1u == (tg + 1u) * nx) xb_add(&bar[XB_TOPGEN], 1u);
            else XB_SPIN(xb_ld(&bar[XB_TOPGEN]) == tg, bar);
            __builtin_amdgcn_fence(__ATOMIC_ACQUIRE, "agent");
            xb_add(&bar[XB_XGEN(b.x)], 1u);
            asm volatile("s_waitcnt vmcnt(0)" ::: "memory");
        } else {
            XB_SPIN(xb_ld(&bar[XB_XGEN(b.x)]) == gen, bar);
            __builtin_amdgcn_fence(__ATOMIC_ACQUIRE, "agent");
            asm volatile("s_waitcnt vmcnt(0)" ::: "memory");
        }
    }
    __syncthreads();
}

template <int PH> __device__ __forceinline__ void run_phase(const Params& p, float* smem, int bid, int nb) {
    if constexpr (PH == 0) { phase_ada(p, smem, bid, nb); phase_rope(p, bid, nb); }
    else if constexpr (PH == 1) { phase_ln_in(p, bid, nb); phase_wprep(p, smem, bid, nb); }
    else if constexpr (PH == 2) { EpiInP e{p.ws, p.b_gate}; gemm_pg8((unsigned char*)smem, (const bf16_t*)(p.ws + WS_XN), (const bf16_t*)(p.ws + WS_WIN), M, N_INX, D, e); }
    else if constexpr (PH == 3) gla::phase_g1(p, (unsigned char*)smem);
    else if constexpr (PH == 4) gla::phase_g2(p, bid, nb);
    else if constexpr (PH == 5) { attn::phase_attn(p, (unsigned char*)smem); gla::phase_g3(p, (unsigned char*)smem); }
    else if constexpr (PH == 6) { EpiOutP e{&p}; gemm_pg8((unsigned char*)smem, (const bf16_t*)(p.ws + WS_MIX), (const bf16_t*)(p.ws + WS_WOUT), M, D, D, e); }
    else if constexpr (PH == 7) phase_ln_rows<false>(p, p.out, p.ln_attn_g, p.ln_attn_b, (bf16_t*)(p.ws + WS_XN), (float*)(p.ws + WS_STATS2), 3072, 4096, bid, nb);
    else if constexpr (PH == 8) {
        EpiUpConv e{&p, (bf16_t*)(p.ws + WS_ACT), (PG8_LAS float*)((PG8_LAS unsigned char*)(unsigned char*)smem + XL_OFF)};
        pg8::Gemm g{(const bf16_t*)(p.ws + WS_XN) - 2 * D, (const bf16_t*)(p.ws + WS_WUP), 65 * 256, F2, D, 254}; pg8::StaticOrder S; S.init(65 * 256, F2, (int)gridDim.x, (int)blockIdx.x);
        pg8::gemm_phase<EpiUpConv, pg8::StaticOrder, true, true>((PG8_LAS unsigned char*)(unsigned char*)smem, g, S, e); }
    else if constexpr (PH == 9) { EpiDownP e{&p, 0}; gemm_pg8((unsigned char*)smem, (const bf16_t*)(p.ws + WS_ACT), (const bf16_t*)(p.ws + WS_WDOWN), M, D, F, e); }
    else if constexpr (PH == 10) phase_ln_rows<true>(p, p.out, p.ln_ffn_g, p.ln_ffn_b, nullptr, nullptr, 0, 0, bid, nb);
}
constexpr int LAST_PHASE = 10;

constexpr int NTHREADS = 512;
constexpr int LDS_BYTES = 147456;

template <int PH> __global__ void __launch_bounds__(NTHREADS, 2) k_phase(Params p) {
    extern __shared__ __attribute__((aligned(16))) unsigned char lds[];
    run_phase<PH>(p, (float*)lds, blockIdx.x, gridDim.x);
}
constexpr int MISC_OFF = 135168;
constexpr int CW_BAR = 4096;
constexpr size_t CTL_ZERO_BYTES = 65536;
#ifndef PROBE_K
#define PROBE_K (-1)
#endif
template <int PH> struct PhaseLoop { static __device__ __forceinline__ void run(const Params& p, float* smem, const XcdBarrier& bar) {
    run_phase<PH>(p, smem, blockIdx.x, gridDim.x);
    if constexpr (PH < LAST_PHASE) { xcd_barrier(bar);
        if (PROBE_K == PH && blockIdx.x == 0 && threadIdx.x == 0) bar.st[8] = (unsigned)__builtin_amdgcn_s_memrealtime();
        PhaseLoop<PH + 1>::run(p, smem, bar); } } };
__global__ void __launch_bounds__(NTHREADS, 2) k_mega(Params p) {
    extern __shared__ __attribute__((aligned(16))) unsigned char lds[];
    volatile LAS unsigned* misc = (volatile LAS unsigned*)((LAS unsigned char*)lds + MISC_OFF);
    if (threadIdx.x < 32) misc[threadIdx.x] = 0u;
    __syncthreads();
    const XcdBarrier bar = xcd_barrier_post((unsigned*)(p.ws + WS_CTL) + CW_BAR, misc + 8);
    if (PROBE_K >= 0 && blockIdx.x == 0 && threadIdx.x == 0) misc[17] = (unsigned)__builtin_amdgcn_s_memrealtime();
    PhaseLoop<0>::run(p, (float*)lds, bar);
    if (PROBE_K >= 0 && blockIdx.x == 0 && threadIdx.x == 0) {
        const unsigned want = misc[16] - misc[17]; const unsigned t0 = (unsigned)__builtin_amdgcn_s_memrealtime();
        while ((unsigned)__builtin_amdgcn_s_memrealtime() - t0 < want) __builtin_amdgcn_s_sleep(4);
    }
}

template <int PH> static void launch_phases(const Params& p, int grid, hipStream_t stream) {
    static bool attr_set = false;
    if (!attr_set) { (void)hipFuncSetAttribute((const void*)k_phase<PH>, hipFuncAttributeMaxDynamicSharedMemorySize, LDS_BYTES); attr_set = true; }
    hipLaunchKernelGGL(k_phase<PH>, dim3(grid), dim3(NTHREADS), LDS_BYTES, stream, p);
    if constexpr (PH < LAST_PHASE) launch_phases<PH + 1>(p, grid, stream);
}

extern "C" void kernel_launch(void* const* d_in, const int* in_sizes, int n_in, void* d_out, int out_size, void* d_ws, size_t ws_size, hipStream_t stream) {
    if (n_in != 25 || in_sizes[0] != M * D || out_size != M * D || ws_size < WS_END) {
        fprintf(stderr, "kernel_launch: unexpected shapes (n_in %d, in0 %d, out %d, ws %zu)\n", n_in, n_in > 0 ? in_sizes[0] : -1, out_size, ws_size); return; }
    Params p{};
    p.x = (const float*)d_in[0]; p.c = (const float*)d_in[1]; p.pos = (const int*)d_in[2]; p.ln_in_g = (const float*)d_in[3]; p.ln_in_b = (const float*)d_in[4];
    p.w_ada = (const float*)d_in[5]; p.b_ada = (const float*)d_in[6]; p.w_in = (const float*)d_in[7];
    p.lq1 = (const float*)d_in[8]; p.lk1 = (const float*)d_in[9]; p.lq2 = (const float*)d_in[10]; p.lk2 = (const float*)d_in[11];
    p.diff_norm_w = (const float*)d_in[12]; p.w_gate_up = (const float*)d_in[13]; p.b_gate = (const float*)d_in[14]; p.gla_norm_w = (const float*)d_in[15];
    p.w_out = (const float*)d_in[16]; p.ln_attn_g = (const float*)d_in[17]; p.ln_attn_b = (const float*)d_in[18];
    p.w_up = (const float*)d_in[19]; p.conv_w = (const float*)d_in[20]; p.conv_b = (const float*)d_in[21]; p.w_down = (const float*)d_in[22];
    p.ln_ffn_g = (const float*)d_in[23]; p.ln_ffn_b = (const float*)d_in[24];
    p.out = (float*)d_out; p.ws = (unsigned char*)d_ws;
#if ONE_LAUNCH
    static int grid_blocks = 0;
    if (!grid_blocks) {
        int dev = 0, cus = 0, per_cu = 0;
        (void)hipGetDevice(&dev); (void)hipDeviceGetAttribute(&cus, hipDeviceAttributeMultiprocessorCount, dev);
        (void)hipFuncSetAttribute((const void*)k_mega, hipFuncAttributeMaxDynamicSharedMemorySize, LDS_BYTES);
        (void)hipOccupancyMaxActiveBlocksPerMultiprocessor(&per_cu, (const void*)k_mega, NTHREADS, LDS_BYTES);
        if (per_cu != 1) fprintf(stderr, "note: occupancy query says %d workgroups per CU (expected 1)\n", per_cu);
        grid_blocks = cus;
    }
    (void)hipMemsetAsync((unsigned char*)d_ws + WS_CTL, 0, CTL_ZERO_BYTES, stream);
    void* args[] = {&p};
    hipError_t e = hipLaunchCooperativeKernel((const void*)k_mega, dim3(grid_blocks), dim3(NTHREADS), args, LDS_BYTES, stream);
    if (e != hipSuccess) fprintf(stderr, "cooperative launch failed: %s (grid %d)\n", hipGetErrorString(e), grid_blocks);
#else
    launch_phases<0>(p, 256, stream);
#endif
}
```
